# Optimizing an MI355X kernel written in HIP

```python
import math
import jax, jax.numpy as jnp
from jax import lax
import numpy as np

D_MODEL = 1024
BATCH = 8
SEQ = 8192
DEPTH = 2

HEAD_DIM = 64
N_HEADS_A = 8
WIDTH_A = N_HEADS_A * HEAD_DIM
KV_RANK = 128
N_IDX_HEADS = 4
IDX_DIM = 64
INDEX_TOPK = 256
N_HEADS_B = 8
WIDTH_B = N_HEADS_B * HEAD_DIM
Q_BLOCK = 128
N_BUCKETS = 32
MAX_DISTANCE = 128
N_EXPERTS = 32
TOP_K = 4
D_EXPERT = 1024
SWIGLU_LIMIT = 7.0
SWIGLU_ALPHA = 1.702
MOE_BLOCK = 256
LN_EPS = 1e-5
RMS_EPS = 1e-6
DN_ALPHA = (2 * DEPTH) ** 0.25
DN_BETA = (8 * DEPTH) ** -0.25
COL_SPLITS = (WIDTH_A, KV_RANK, N_IDX_HEADS * IDX_DIM, IDX_DIM, N_IDX_HEADS,
              WIDTH_B, WIDTH_B, WIDTH_B, D_MODEL, D_MODEL)
N_COLS = sum(COL_SPLITS)

kernel_name = "hybrid_dsa_stickbreak_moe_deepnorm"


def layer_norm_f32(x):
    xf = x.astype(jnp.float32)
    mu = jnp.mean(xf, axis=-1, keepdims=True)
    var = jnp.mean(jnp.square(xf - mu), axis=-1, keepdims=True)
    return (xf - mu) * lax.rsqrt(var + LN_EPS)


def modulate(x, shift, scale):
    return (layer_norm_f32(x) * (1.0 + scale.astype(jnp.float32)) + shift.astype(jnp.float32)).astype(x.dtype)


def post_norm(z, g, b):
    return (layer_norm_f32(z) * g.astype(jnp.float32) + b.astype(jnp.float32)).astype(z.dtype)


def rms_norm(x, g):
    xf = x.astype(jnp.float32)
    y = xf * lax.rsqrt(jnp.mean(xf * xf, axis=-1, keepdims=True) + RMS_EPS)
    return (y * g.astype(jnp.float32)).astype(x.dtype)


def split_cols(p):
    out, o = [], 0
    for w in COL_SPLITS:
        out.append(p[..., o:o + w])
        o += w
    return out


def t5_bucket(n):
    max_exact = N_BUCKETS // 2
    nf = jnp.maximum(n, 1).astype(jnp.float32)
    large = max_exact + (jnp.log(nf / max_exact) / math.log(MAX_DISTANCE / max_exact)
                         * (N_BUCKETS - max_exact)).astype(jnp.int32)
    large = jnp.minimum(large, N_BUCKETS - 1)
    return jnp.where(n < max_exact, n, large)


def dsa_attention(q_lat, c_kv, q_idx, k_idx, w_idx, rel_bias):
    B, S = c_kv.shape[:2]
    n_blocks = S // Q_BLOCK
    topk = min(INDEX_TOPK, S // 4)
    key_pos = jnp.arange(S)

    def block(i):
        t0 = i * Q_BLOCK
        qpos = t0 + jnp.arange(Q_BLOCK)
        qi = lax.dynamic_slice_in_dim(q_idx, t0, Q_BLOCK, axis=1)
        wi = lax.dynamic_slice_in_dim(w_idx, t0, Q_BLOCK, axis=1)
        ql = lax.dynamic_slice_in_dim(q_lat, t0, Q_BLOCK, axis=1)
        dots = jax.nn.relu(jnp.einsum('bthd,bsd->bths', qi, k_idx).astype(jnp.float32))
        score = jnp.einsum('bths,bth->bts', dots, wi.astype(jnp.float32))
        causal = key_pos[None, :] <= qpos[:, None]
        score = jnp.where(causal[None], score, -jnp.inf)
        _, sel = lax.top_k(score, topk)
        c_sel = jax.vmap(lambda cb, ib: jnp.take(cb, ib, axis=0))(c_kv, sel)
        logits = jnp.einsum('bthr,btkr->bthk', ql, c_sel).astype(jnp.float32)
        dist = qpos[None, :, None] - sel
        bias = rel_bias[t5_bucket(jnp.maximum(dist, 0))]
        logits = logits + jnp.moveaxis(bias, -1, 2).astype(jnp.float32)
        logits = jnp.where((dist >= 0)[:, :, None, :], logits, -jnp.inf)
        p = jax.nn.softmax(logits, axis=-1).astype(c_kv.dtype)
        return jnp.einsum('bthk,btkr->bthr', p, c_sel)

    o = lax.map(block, jnp.arange(n_blocks))
    return jnp.moveaxis(o, 0, 1).reshape(B, S, N_HEADS_A, KV_RANK)


def stick_breaking_attention(q, k, v):
    B, S = q.shape[:2]
    n_blocks = S // Q_BLOCK
    key_pos = jnp.arange(S)
    scale = HEAD_DIM ** -0.5

    def block(i):
        t0 = i * Q_BLOCK
        qpos = t0 + jnp.arange(Q_BLOCK)
        qb = lax.dynamic_slice_in_dim(q, t0, Q_BLOCK, axis=1)
        z = jnp.einsum('bthd,bshd->bhts', qb, k).astype(jnp.float32) * scale
        strict = (key_pos[None, :] < qpos[:, None])[None, None]
        log_fail = jnp.where(strict, jax.nn.log_sigmoid(-z), 0.0)
        later = lax.cumsum(log_fail, axis=3, reverse=True) - log_fail
        a = jnp.where(strict, jnp.exp(jax.nn.log_sigmoid(z) + later), 0.0)
        return jnp.einsum('bhts,bshd->bthd', a.astype(v.dtype), v)

    o = lax.map(block, jnp.arange(n_blocks))
    return jnp.moveaxis(o, 0, 1).reshape(B, S, WIDTH_B)


def moe_ffn(h, w_router, b_router, w_gu, b_gu, w_dn, b_dn):
    B, S, D = h.shape
    N = B * S
    xt = h.reshape(N, D)
    logits = (xt @ w_router + b_router).astype(jnp.float32)
    top_val, top_idx = lax.top_k(logits, TOP_K)
    gate = jax.nn.softmax(top_val, axis=-1)
    flat_e = top_idx.reshape(-1)
    flat_g = gate.reshape(-1)
    order = jnp.argsort(flat_e)
    sorted_e = flat_e[order]
    token = (order // TOP_K).astype(jnp.int32)
    counts = jnp.zeros((N_EXPERTS,), jnp.int32).at[flat_e].add(1)
    padded = (counts + MOE_BLOCK - 1) // MOE_BLOCK * MOE_BLOCK
    start = jnp.cumsum(counts) - counts
    pad_end = jnp.cumsum(padded)
    pad_start = pad_end - padded
    dest = pad_start[sorted_e] + jnp.arange(N * TOP_K, dtype=jnp.int32) - start[sorted_e]
    n_blocks = -(-(N * TOP_K + N_EXPERTS * (MOE_BLOCK - 1)) // MOE_BLOCK)
    rows = n_blocks * MOE_BLOCK
    row_token = jnp.full((rows,), N, jnp.int32).at[dest].set(token)
    row_gate = jnp.zeros((rows,), jnp.float32).at[dest].set(flat_g[order])
    block_expert = jnp.minimum(
        jnp.searchsorted(pad_end, jnp.arange(n_blocks, dtype=jnp.int32) * MOE_BLOCK, side='right'),
        N_EXPERTS - 1)
    x_pad = jnp.concatenate([xt, jnp.zeros((1, D), xt.dtype)], axis=0)

    def expert_block(args):
        tok, g, e = args
        xb = x_pad[tok]
        gu = xb @ w_gu[e] + b_gu[e]
        a, u = jnp.split(gu, 2, axis=-1)
        a = jnp.minimum(a, SWIGLU_LIMIT)
        u = jnp.clip(u, -SWIGLU_LIMIT, SWIGLU_LIMIT)
        y = ((u + 1.0) * a * jax.nn.sigmoid(SWIGLU_ALPHA * a)) @ w_dn[e] + b_dn[e]
        return y * g[:, None].astype(y.dtype)

    ys = lax.map(expert_block, (row_token.reshape(n_blocks, MOE_BLOCK),
                                row_gate.reshape(n_blocks, MOE_BLOCK), block_expert))
    out = jax.ops.segment_sum(ys.reshape(rows, D), row_token, num_segments=N + 1)[:N]
    return out.reshape(B, S, D)


def setup_inputs(seed: int = 0) -> dict:
    key = jax.random.key(seed)
    ks = jax.random.split(key, 24)
    L, D, E, F = DEPTH, D_MODEL, N_EXPERTS, D_EXPERT

    def nrm(k, shape, s):
        return jax.random.normal(k, shape, jnp.float32) * s

    col_scale = jnp.concatenate([
        jnp.ones((sum(COL_SPLITS[:7]),), jnp.float32),
        jnp.full((WIDTH_B,), DN_BETA, jnp.float32),
        jnp.ones((2 * D,), jnp.float32)])
    return {
        "x": nrm(ks[0], (BATCH, SEQ, D), 1.0),
        "c": nrm(ks[1], (BATCH, D), 1.0),
        "rel_bias": nrm(ks[2], (N_BUCKETS, N_HEADS_A), 0.5),
        "w_ada": nrm(ks[3], (L, D, 6 * D), 0.5 * D ** -0.5),
        "b_ada": nrm(ks[4], (L, 6 * D), 0.01),
        "w_in": nrm(ks[5], (L, D, N_COLS), D ** -0.5) * col_scale,
        "g_kv": 1.0 + nrm(ks[6], (L, KV_RANK), 0.02),
        "w_uk": nrm(ks[7], (L, KV_RANK, N_HEADS_A, HEAD_DIM), KV_RANK ** -0.5),
        "w_uv": nrm(ks[8], (L, KV_RANK, N_HEADS_A, HEAD_DIM), KV_RANK ** -0.5 * DN_BETA),
        "w_a_out": nrm(ks[9], (L, WIDTH_A, D), WIDTH_A ** -0.5 * DN_BETA),
        "w_b_out": nrm(ks[10], (L, WIDTH_B, D), WIDTH_B ** -0.5 * DN_BETA),
        "w_o": nrm(ks[11], (L, D, D), D ** -0.5 * DN_BETA),
        "ln1_g": 1.0 + nrm(ks[12], (L, D), 0.02),
        "ln1_b": nrm(ks[13], (L, D), 0.01),
        "w_router": nrm(ks[14], (L, D, E), D ** -0.5),
        "b_router": nrm(ks[15], (L, E), 0.01),
        "w_gu": nrm(ks[16], (L, E, D, 2 * F), D ** -0.5),
        "b_gu": nrm(ks[17], (L, E, 2 * F), 0.01),
        "w_dn": nrm(ks[18], (L, E, F, D), F ** -0.5 * DN_BETA),
        "b_dn": nrm(ks[19], (L, E, D), 0.01),
        "ln2_g": 1.0 + nrm(ks[20], (L, D), 0.02),
        "ln2_b": nrm(ks[21], (L, D), 0.01),
    }


def reference(x, c, rel_bias, w_ada, b_ada, w_in, g_kv, w_uk, w_uv, w_a_out, w_b_out, w_o,
              ln1_g, ln1_b, w_router, b_router, w_gu, b_gu, w_dn, b_dn, ln2_g, ln2_b):
    B, S, D = x.shape
    cond = jax.nn.silu(c)
    idx_scale = (N_IDX_HEADS ** -0.5) * (IDX_DIM ** -0.5)
    for l in range(DEPTH):
        mod = cond @ w_ada[l] + b_ada[l]
        shift1, scale1, gate1, shift2, scale2, gate2 = [m[:, None, :] for m in jnp.split(mod, 6, axis=-1)]

        h = modulate(x, shift1, scale1)
        q_a, c_kv, q_idx, k_idx, w_idx, q_b, k_b, v_b, g_a, g_b = split_cols(h @ w_in[l])
        c_kv = rms_norm(c_kv, g_kv[l])
        q_a = q_a.reshape(B, S, N_HEADS_A, HEAD_DIM)
        q_lat = jnp.einsum('bshd,rhd->bshr', q_a, w_uk[l]) * (HEAD_DIM ** -0.5)
        o_lat = dsa_attention(q_lat, c_kv,
                              q_idx.reshape(B, S, N_IDX_HEADS, IDX_DIM), k_idx,
                              w_idx * idx_scale, rel_bias)
        o_a = jnp.einsum('bshr,rhd->bshd', o_lat, w_uv[l]).reshape(B, S, WIDTH_A)
        o_b = stick_breaking_attention(q_b.reshape(B, S, N_HEADS_B, HEAD_DIM),
                                       k_b.reshape(B, S, N_HEADS_B, HEAD_DIM),
                                       v_b.reshape(B, S, N_HEADS_B, HEAD_DIM))
        merged = jax.nn.sigmoid(g_a) * (o_a @ w_a_out[l]) + jax.nn.sigmoid(g_b) * (o_b @ w_b_out[l])
        y = merged @ w_o[l]
        x = post_norm(DN_ALPHA * x + gate1 * y, ln1_g[l], ln1_b[l])

        h = modulate(x, shift2, scale2)
        y = moe_ffn(h, w_router[l], b_router[l], w_gu[l], b_gu[l], w_dn[l], b_dn[l])
        x = post_norm(DN_ALPHA * x + gate2 * y, ln2_g[l], ln2_b[l])
    return x
```

```cpp
#include <hip/hip_runtime.h>
#include <cstdio>
#include <cstdint>
#include <cmath>

#define LAS __attribute__((address_space(3)))
#define GAS __attribute__((address_space(1)))
typedef unsigned short bf16_t;
typedef short bf16x8 __attribute__((ext_vector_type(8)));
typedef short s16x4 __attribute__((ext_vector_type(4)));
typedef float f32x4 __attribute__((ext_vector_type(4)));
typedef float f32x2 __attribute__((ext_vector_type(2)));
typedef __bf16 bf16x2_t __attribute__((ext_vector_type(2)));
typedef float f32x16 __attribute__((ext_vector_type(16)));
typedef unsigned u32x4 __attribute__((ext_vector_type(4)));
typedef unsigned u32x2 __attribute__((ext_vector_type(2)));
typedef GAS unsigned gu32;
#define RLX_AGENT __ATOMIC_RELAXED, __HIP_MEMORY_SCOPE_AGENT
#define DI __device__ __forceinline__

DI unsigned cvt_pk_bf16(float lo, float hi) { const f32x2 v = {lo, hi}; const bf16x2_t b = __builtin_convertvector(v, bf16x2_t); return __builtin_bit_cast(unsigned, b); }
DI float bf_lo(unsigned u) { return __uint_as_float(u << 16); }
DI float bf_hi(unsigned u) { return __uint_as_float(u & 0xffff0000u); }
DI float fast_exp2(float x) { return __builtin_amdgcn_exp2f(x); }
DI float fast_log2(float x) { return __builtin_amdgcn_logf(x); }
DI float fast_rcp(float x) { return __builtin_amdgcn_rcpf(x); }
DI float sigmoidf_(float x) { return fast_rcp(1.0f + fast_exp2(-1.4426950408889634f * x)); }

namespace pg8 {
constexpr int BM = 256, BK = 64, HALF = 128, HTB = HALF * BK * 2, STAGE_BYTES = 8 * HTB;
__host__ __device__ __forceinline__ int lds_byte(int r, int c) { const int st = (r >> 4) * 2 + (c >> 5), rr = r & 15, cc = c & 31, ob = rr * 64 + cc * 2; return st * 1024 + (ob ^ (((ob >> 9) & 1) << 5)); }
__host__ __device__ __forceinline__ void stage_rc(int b, int& R, int& C) { const int st = b / 1024, sb = b % 1024, swz = sb ^ (((sb >> 9) & 1) << 5); R = (st >> 1) * 16 + swz / 64; C = (st & 1) * 32 + (swz % 64) / 2; }
__host__ __device__ __forceinline__ int perm32(int rho) { const int n = rho >> 4, i = rho & 15; return 8 * (i >> 2) + 4 * n + (i & 3); }
struct Unit { int pm, pn, aux; };
template <class Epi, class Sched>
__device__ __forceinline__ void gemm_phase(LAS unsigned char* lds, const bf16_t* Abase_, const int K, const Sched& S, const Epi& E) {
    int tid_ = threadIdx.x; asm volatile("" : "+v"(tid_));
    const int tid = tid_, wid = __builtin_amdgcn_readfirstlane(tid >> 6), lane = tid & 63, wr = wid >> 2, wc = wid & 3, fr = lane & 15, fq = lane >> 4;
    const int nt = K / BK;
    const char* Abase = (const char*)Abase_;
    int Rr[2], Cc[2]; unsigned voffB[2];
#pragma unroll
    for (int i = 0; i < 2; ++i) { int R, C; stage_rc(tid * 16 + i * 8192, R, C); Rr[i] = R; Cc[i] = C; const int Rb = (R & ~31) + perm32(R & 31); voffB[i] = (unsigned)(Rb * K + C) * 2u; }
    const size_t kstep = (size_t)(BK * 2);
    const size_t hstep = (size_t)HALF * K * 2;
    const unsigned ldsw = (unsigned)wid * 1024u;
    const int aoff = lds_byte(wr * 64 + fr, fq * 8), boff = lds_byte(wc * 32 + fr, fq * 8);
#define PG8_SA(b, h) (((b) * 2 + (h)) * HTB)
#define PG8_SB(b, h) ((4 + (b) * 2 + (h)) * HTB)
#define PG8_STAGE_B(bufoff, gbase) do { const char* _gb = (const char*)(gbase); asm volatile("" : "+s"(_gb)); _Pragma("unroll") for (int _i = 0; _i < 2; ++_i) \
        __builtin_amdgcn_global_load_lds((const unsigned*)(_gb + voffB[_i]), (LAS unsigned*)(lds + (bufoff) + ldsw + _i * 8192), 16, 0, 0); } while (0)
#define PG8_STAGE_A(bufoff, kb, o0, o1) do { const char* _ga = Abase + (size_t)(kb); asm volatile("" : "+s"(_ga)); \
        __builtin_amdgcn_global_load_lds((const unsigned*)(_ga + (o0)), (LAS unsigned*)(lds + (bufoff) + ldsw), 16, 0, 0); \
        __builtin_amdgcn_global_load_lds((const unsigned*)(_ga + (o1)), (LAS unsigned*)(lds + (bufoff) + ldsw + 8192), 16, 0, 0); } while (0)
#define PG8_LDA(dst, b, h) do { _Pragma("unroll") for (int m = 0; m < 4; ++m) _Pragma("unroll") for (int k = 0; k < 2; ++k) dst[m][k] = *(const LAS bf16x8*)(lds + PG8_SA(b, h) + aoff + m * 2048 + k * 1024); } while (0)
#define PG8_LDB(dst, b, h) do { _Pragma("unroll") for (int n = 0; n < 2; ++n) _Pragma("unroll") for (int k = 0; k < 2; ++k) dst[n][k] = *(const LAS bf16x8*)(lds + PG8_SB(b, h) + boff + n * 2048 + k * 1024); } while (0)
#define PG8_MMA(ai, bj, At, Bt) do { __builtin_amdgcn_s_setprio(1); _Pragma("unroll") for (int m = 0; m < 4; ++m) _Pragma("unroll") for (int n = 0; n < 2; ++n) _Pragma("unroll") for (int k = 0; k < 2; ++k) \
        acc[ai][bj][m][n] = __builtin_amdgcn_mfma_f32_16x16x32_bf16(Bt[n][k], At[m][k], acc[ai][bj][m][n], 0, 0, 0); __builtin_amdgcn_s_setprio(0); } while (0)
#define PG8_WAIT_V(n) asm volatile("s_waitcnt vmcnt(" #n ")" ::: "memory")
#define PG8_WAIT_L(n) asm volatile("s_waitcnt lgkmcnt(" #n ")" ::: "memory")
#define PG8_BAR __builtin_amdgcn_s_barrier()
#define PG8_SCHED __builtin_amdgcn_sched_barrier(0)
    Unit cur, nxt; int ui = 0;
    if (!S.next(0, cur)) return;
    f32x4 acc[2][2][4][2];
#pragma unroll
    for (int a = 0; a < 2; ++a)
#pragma unroll
        for (int b = 0; b < 2; ++b)
#pragma unroll
            for (int m = 0; m < 4; ++m)
#pragma unroll
                for (int n = 0; n < 2; ++n) acc[a][b][m][n] = (f32x4){0.f, 0.f, 0.f, 0.f};
    bf16x8 At[4][2], B0[2][2], B1[2][2];
    unsigned c00 = S.a_row_off(cur, Rr[0]) + Cc[0] * 2u, c01 = S.a_row_off(cur, Rr[1]) + Cc[1] * 2u, c10 = S.a_row_off(cur, HALF + Rr[0]) + Cc[0] * 2u, c11 = S.a_row_off(cur, HALF + Rr[1]) + Cc[1] * 2u;
    unsigned n00 = c00, n01 = c01, n10 = c10, n11 = c11;
    const char* cB = S.b_tile(cur); const char* nB = cB;
    PG8_STAGE_B(PG8_SB(0, 0), cB); PG8_STAGE_B(PG8_SB(0, 1), cB + hstep); PG8_STAGE_A(PG8_SA(0, 0), 0, c00, c01); PG8_STAGE_A(PG8_SA(0, 1), 0, c10, c11);
    if (wr == 1) PG8_BAR;
    PG8_WAIT_V(2); PG8_BAR;
    PG8_STAGE_B(PG8_SB(1, 0), cB + kstep); PG8_STAGE_A(PG8_SA(1, 0), kstep, c00, c01); PG8_STAGE_B(PG8_SB(1, 1), cB + hstep + kstep);
    PG8_WAIT_V(6); PG8_BAR;
    for (;;) {
        const bool has_next = S.next(ui + 1, nxt);
        if (has_next) { n00 = S.a_row_off(nxt, Rr[0]) + Cc[0] * 2u; n01 = S.a_row_off(nxt, Rr[1]) + Cc[1] * 2u; n10 = S.a_row_off(nxt, HALF + Rr[0]) + Cc[0] * 2u; n11 = S.a_row_off(nxt, HALF + Rr[1]) + Cc[1] * 2u; nB = S.b_tile(nxt); }
        else { n00 = c00; n01 = c01; n10 = c10; n11 = c11; nB = cB; }
        for (int t = 0; t < nt; t += 2) {
            const bool last = (t == nt - 2);
            const size_t k1 = (size_t)(t + 1) * kstep;
            const size_t k2 = last ? 0 : (size_t)(t + 2) * kstep, k3 = k2 + kstep;
            const char* b2 = last ? nB : cB + (size_t)(t + 2) * kstep; const char* b3 = b2 + kstep;
            const unsigned o00 = last ? n00 : c00, o01 = last ? n01 : c01, o10 = last ? n10 : c10, o11 = last ? n11 : c11;
            PG8_LDB(B0, 0, 0); PG8_LDB(B1, 0, 1); PG8_SCHED; PG8_LDA(At, 0, 0); PG8_STAGE_A(PG8_SA(1, 1), k1, c10, c11);
            PG8_WAIT_V(8); PG8_WAIT_L(0); PG8_BAR; PG8_MMA(0, 0, At, B0); PG8_MMA(0, 1, At, B1); PG8_BAR; PG8_SCHED;
            PG8_LDA(At, 0, 1); PG8_STAGE_B(PG8_SB(0, 0), b2); PG8_STAGE_B(PG8_SB(0, 1), b2 + hstep); PG8_STAGE_A(PG8_SA(0, 0), k2, o00, o01);
            PG8_WAIT_V(8); PG8_WAIT_L(0); PG8_BAR; PG8_MMA(1, 0, At, B0); PG8_MMA(1, 1, At, B1); PG8_BAR; PG8_SCHED;
            PG8_LDB(B0, 1, 0); PG8_LDB(B1, 1, 1); PG8_SCHED; PG8_LDA(At, 1, 0); PG8_STAGE_A(PG8_SA(0, 1), k2, o10, o11);
            PG8_WAIT_V(8); PG8_WAIT_L(0); PG8_BAR; PG8_MMA(0, 0, At, B0); PG8_MMA(0, 1, At, B1); PG8_BAR; PG8_SCHED;
            PG8_LDA(At, 1, 1); PG8_STAGE_B(PG8_SB(1, 0), b3); PG8_STAGE_B(PG8_SB(1, 1), b3 + hstep); PG8_STAGE_A(PG8_SA(1, 0), k3, o00, o01);
            PG8_WAIT_V(8); PG8_WAIT_L(0); PG8_BAR; PG8_MMA(1, 0, At, B0); PG8_MMA(1, 1, At, B1); PG8_BAR; PG8_SCHED;
        }
        if (wr == 0) PG8_BAR;
        E(acc, cur, wr, wc, fr, fq);
        if (!has_next) break;
#pragma unroll
        for (int a = 0; a < 2; ++a)
#pragma unroll
            for (int b = 0; b < 2; ++b)
#pragma unroll
                for (int m = 0; m < 4; ++m)
#pragma unroll
                    for (int n = 0; n < 2; ++n) acc[a][b][m][n] = (f32x4){0.f, 0.f, 0.f, 0.f};
        cur = nxt; c00 = n00; c01 = n01; c10 = n10; c11 = n11; cB = nB; ++ui;
        if (wr == 1) PG8_BAR;
    }
    PG8_WAIT_V(0);
    PG8_BAR;
#undef PG8_SA
#undef PG8_SB
#undef PG8_STAGE_A
#undef PG8_STAGE_B
#undef PG8_LDA
#undef PG8_LDB
#undef PG8_MMA
#undef PG8_WAIT_V
#undef PG8_WAIT_L
#undef PG8_BAR
#undef PG8_SCHED
}
}
#define XB_TMO      128
#define XB_XCNT(j)  (256  + 64 * (j))
#define XB_XSUB(j)  (1280 + 64 * (j))
#define XB_XGEN(j)  (2304 + 64 * (j))
#define XB_TOP      3328
#define XB_TOPGEN   3392
#define XCD_BAR_WORDS 3456
#define XB_SPIN_CAP (1u << 18)

__device__ __forceinline__ unsigned xb_ld(unsigned* p)              { return __hip_atomic_load(p, __ATOMIC_RELAXED, __HIP_MEMORY_SCOPE_AGENT); }
__device__ __forceinline__ unsigned xb_add(unsigned* p, unsigned v) { return __hip_atomic_fetch_add(p, v, __ATOMIC_RELAXED, __HIP_MEMORY_SCOPE_AGENT); }
__device__ __forceinline__ unsigned xb_xcc_id() { return (unsigned)__builtin_amdgcn_s_getreg((3 << 11) | 20) & 0xFu; }
#define XB_SPIN(cond, bar) do { unsigned _sp = 0; while (cond) { __builtin_amdgcn_s_sleep(1); \
    if ((++_sp & 255u) == 0u) { if (xb_ld(&(bar)[XB_TMO])) break; if (_sp > XB_SPIN_CAP) { atomicAdd(&(bar)[XB_TMO], 1u); break; } } } } while (0)

struct XcdBarrier {
    unsigned* bar; unsigned x;
    volatile LAS unsigned* st;
};

__device__ __forceinline__ XcdBarrier xcd_barrier_post(unsigned* bar, volatile LAS unsigned* st) {
    XcdBarrier b; b.bar = bar; b.x = xb_xcc_id(); b.st = st;
    if (threadIdx.x == 0) (void)xb_add(&bar[XB_XCNT(b.x)], 1u);
    return b;
}
__device__ __forceinline__ void xcd_barrier_complete(unsigned* bar, unsigned x, unsigned& nloc, unsigned& nx) {
    const unsigned G = gridDim.x * gridDim.y * gridDim.z;
    unsigned sum, cnt, mine, sp = 0u;
    for (;;) {
        sum = 0u; cnt = 0u; mine = 0u;
#pragma unroll
        for (unsigned j = 0; j < 16; ++j) { const unsigned c = xb_ld(&bar[XB_XCNT(j)]); sum += c; cnt += (c > 0u) ? 1u : 0u; mine = (j == x) ? c : mine; }
        if (sum == G) break;
        __builtin_amdgcn_s_sleep(1);
        if ((++sp & 255u) == 0u) { if (xb_ld(&bar[XB_TMO])) break; if (sp > XB_SPIN_CAP) { atomicAdd(&bar[XB_TMO], 1u); break; } }
    }
    nloc = mine > 0u ? mine : 1u; nx = cnt > 0u ? cnt : 1u;
}

__device__ __forceinline__ void xcd_barrier(const XcdBarrier& b) {
    asm volatile("s_waitcnt vmcnt(0)" ::: "memory");
    __syncthreads();
    if (threadIdx.x == 0) {
        unsigned* bar = b.bar;
        __builtin_amdgcn_s_waitcnt(0);
        unsigned nloc = b.st[0], nx = b.st[1];
        if (nloc == 0u) { xcd_barrier_complete(bar, b.x, nloc, nx); b.st[0] = nloc; b.st[1] = nx; }
        const unsigned old = xb_add(&bar[XB_XSUB(b.x)], 1u);
        const unsigned gen = old / nloc;
        if (old + 1u == (gen + 1u) * nloc) {
            __builtin_amdgcn_fence(__ATOMIC_RELEASE, "agent");
            asm volatile("s_waitcnt vmcnt(0)" ::: "memory");
            const unsigned og = xb_add(&bar[XB_TOP], 1u);
            const unsigned tg = og / nx;
            if (og + 1u == (tg + 1u) * nx) xb_add(&bar[XB_TOPGEN], 1u);
            else XB_SPIN(xb_ld(&bar[XB_TOPGEN]) == tg, bar);
            __builtin_amdgcn_fence(__ATOMIC_ACQUIRE, "agent");
            xb_add(&bar[XB_XGEN(b.x)], 1u);
            asm volatile("s_waitcnt vmcnt(0)" ::: "memory");
        } else {
            XB_SPIN(xb_ld(&bar[XB_XGEN(b.x)]) == gen, bar);
            __builtin_amdgcn_fence(__ATOMIC_ACQUIRE, "agent");
            asm volatile("s_waitcnt vmcnt(0)" ::: "memory");
        }
    }
    __syncthreads();
}

constexpr int NB = 8, SEQ = 8192, DM = 1024, NTOK = NB * SEQ, DEPTH = 2;
constexpr int NHA = 8, KVR = 128, NIH = 4, IDXD = 64, TOPK = 256, NHB = 8, HD = 64;
constexpr int NEXP = 32, MTOPK = 4, DEXP = 1024;
constexpr int NCOLS_SRC = 4548, NCOL = 5120;
constexpr int SRC_CKV = 512, SRC_QIDX = 640, SRC_KIDX = 896, SRC_WIDX = 960, SRC_QB = 964, SRC_KB = 1476, SRC_VB = 1988, SRC_GA = 2500, SRC_GB = 3524;
constexpr int PC_QLAT = 0, PC_MISC = 1024, PC_QIDX = 1280, PC_QB = 1536, PC_KB = 2048, PC_VB = 2560, PC_GA = 3072, PC_GB = 4096;
constexpr float LN_EPS = 1e-5f, RMS_EPS = 1e-6f;
constexpr float DN_ALPHA = 1.4142135623730951f;
constexpr float LOG2E = 1.4426950408889634f;
constexpr float SB_QSCALE = 0.125f * LOG2E;
constexpr float SB_STOP = 48.0f;
constexpr int ACT_ROWS = NTOK * MTOPK + NEXP * 256;

constexpr size_t MiB = 1u << 20;
constexpr size_t WS_CTL = 0, CTL_ZERO_BYTES = 1 * MiB;
constexpr size_t WS_MOD = 1 * MiB, WS_WIDX = 2 * MiB, WS_GATE = 3 * MiB, WS_LIST = 4 * MiB;
constexpr size_t WS_WIN = 12 * MiB, WS_WFA = 32 * MiB, WS_WB = 36 * MiB, WS_WO = 38 * MiB, WS_WGU = 42 * MiB, WS_WDN = 298 * MiB;
constexpr size_t WS_CKV = 426 * MiB, WS_KIDX = 442 * MiB, WS_H = 450 * MiB, WS_ZX = 578 * MiB;
constexpr size_t WS_P = 834 * MiB, WS_ACT = 834 * MiB;
constexpr size_t WS_OLAT = 1474 * MiB, WS_OB = 1602 * MiB, WS_T = 1666 * MiB, WS_MISC = 1666 * MiB, WS_MERGED = 1794 * MiB, WS_YS = 1474 * MiB;
constexpr size_t WS_END = 1986 * MiB;
static_assert(WS_ACT + (size_t)ACT_ROWS * DEXP * 2 <= WS_OLAT, "ACT fits in R1");
static_assert(WS_P + (size_t)NTOK * NCOL * 2 <= WS_OLAT, "P fits in R1");
constexpr int CW_BAR = 4096;
constexpr int CW_CNT = 8192;

constexpr int LDS_BYTES = 163840;
constexpr int MISC_OFF = LDS_BYTES - 512;
constexpr int SCH_OFF = LDS_BYTES - 1024;

#define LDS_WAIT() asm volatile("s_waitcnt lgkmcnt(0)" ::: "memory")
#define VM_WAIT() asm volatile("s_waitcnt vmcnt(0)" ::: "memory")

DI float wave_sum(float v) {
#pragma unroll
    for (int o = 1; o < 64; o <<= 1) v += __shfl_xor(v, o);
    return v;
}

struct Ctx {
    LAS unsigned char* lds;
    int tid, lane, wave, vcu, G;
    const float *x, *c, *rel_bias, *w_ada, *b_ada, *w_in, *g_kv, *w_uk, *w_uv, *w_a_out, *w_b_out, *w_o, *ln1_g, *ln1_b, *w_router, *b_router, *w_gu, *b_gu, *w_dn, *b_dn, *ln2_g, *ln2_b;
    float* out; unsigned char* ws; gu32* ctl;
};

template <class Map>
DI void transpose_item(const float* W, int K, int Nsrc, bf16_t* WT, LAS float* scr, int item, int nblk_dst, int lane, const Map& map) {
    const int kb = item / nblk_dst, nb = item % nblk_dst, k0 = 64 * kb, n0 = 32 * nb;
    const int sc = map(n0 + (lane & 31));
#pragma unroll 8
    for (int i = 0; i < 32; ++i) { const int kk = 2 * i + (lane >> 5); scr[kk * 33 + (lane & 31)] = (sc >= 0) ? W[(size_t)(k0 + kk) * Nsrc + sc] : 0.f; }
    LDS_WAIT(); asm volatile("" ::: "memory");
    const int c = lane & 7;
#pragma unroll
    for (int j = 0; j < 4; ++j) { const int n = (lane >> 3) + 8 * j; const LAS float* s = scr + (8 * c) * 33 + n;
        u32x4 o; o.x = cvt_pk_bf16(s[0 * 33], s[1 * 33]); o.y = cvt_pk_bf16(s[2 * 33], s[3 * 33]); o.z = cvt_pk_bf16(s[4 * 33], s[5 * 33]); o.w = cvt_pk_bf16(s[6 * 33], s[7 * 33]);
        *(GAS u32x4*)(WT + (size_t)(n0 + n) * K + k0 + 8 * c) = o; }
    LDS_WAIT(); asm volatile("" ::: "memory");
}
struct MapIn {
    DI int operator()(int n) const {
        if (n < 1152) return SRC_CKV + (n - 1024);
        if (n < 1216) return SRC_KIDX + (n - 1152);
        if (n < 1220) return SRC_WIDX + (n - 1216);
        if (n < 1280) return -1;
        if (n < 1536) return SRC_QIDX + (n - 1280);
        if (n < 2048) return SRC_QB + (n - 1536);
        if (n < 2560) return SRC_KB + (n - 2048);
        if (n < 3072) return SRC_VB + (n - 2560);
        if (n < 4096) return SRC_GA + (n - 3072);
        return SRC_GB + (n - 4096);
    }
};
struct MapGU { DI int operator()(int n) const { const int t = n >> 8, w = n & 255; return (w < 128) ? (t * 128 + w) : (1024 + t * 128 + (w - 128)); } };
struct MapId { DI int operator()(int n) const { return n; } };

DI void p0_prologue(Ctx& F) {
    LAS float* scr = (LAS float*)(F.lds + F.wave * 16384);
    const int gw = F.vcu * 8 + F.wave, NGW = F.G * 8;
    constexpr int I_IN = 16 * 128, I_GU = 16 * 64, I_DN = 16 * 32, I_B = 8 * 32, I_O = 16 * 32;
    constexpr int T_IN = DEPTH * I_IN, T_GU = DEPTH * NEXP * I_GU, T_DN = DEPTH * NEXP * I_DN, T_B = DEPTH * I_B, T_O = DEPTH * I_O;
    constexpr int NITEMS = T_IN + T_GU + T_DN + T_B + T_O;
    for (int it = gw; it < NITEMS; it += NGW) {
        int r = it;
        if (r < T_GU) { const int m = r / I_GU; transpose_item(F.w_gu + (size_t)m * 1024 * 2048, 1024, 2048, (bf16_t*)(F.ws + WS_WGU) + (size_t)m * 2048 * 1024, scr, r % I_GU, 64, F.lane, MapGU()); continue; } r -= T_GU;
        if (r < T_DN) { const int m = r / I_DN; transpose_item(F.w_dn + (size_t)m * 1024 * 1024, 1024, 1024, (bf16_t*)(F.ws + WS_WDN) + (size_t)m * 1024 * 1024, scr, r % I_DN, 32, F.lane, MapId()); continue; } r -= T_DN;
        if (r < T_IN) { const int l = r / I_IN; const int q = r % I_IN; const int kb = q / 128, nb = q % 128;
            struct M2 { DI int operator()(int n) const { return MapIn()(n + 1024); } };
            transpose_item(F.w_in + (size_t)l * 1024 * NCOLS_SRC, 1024, NCOLS_SRC, (bf16_t*)(F.ws + WS_WIN) + (size_t)l * NCOL * 1024 + (size_t)1024 * 1024, scr, kb * 128 + nb, 128, F.lane, M2()); continue; } r -= T_IN;
        if (r < T_B) { const int l = r / I_B; transpose_item(F.w_b_out + (size_t)l * 512 * 1024, 512, 1024, (bf16_t*)(F.ws + WS_WB) + (size_t)l * 1024 * 512, scr, r % I_B, 32, F.lane, MapId()); continue; } r -= T_B;
        { const int l = r / I_O; transpose_item(F.w_o + (size_t)l * 1024 * 1024, 1024, 1024, (bf16_t*)(F.ws + WS_WO) + (size_t)l * 1024 * 1024, scr, r % I_O, 32, F.lane, MapId()); }
    }
    __syncthreads();
    LAS float* As = (LAS float*)F.lds;
    LAS float* Bs = (LAS float*)(F.lds + 128 * 65 * 4);
    constexpr int J_QL = DEPTH * 8 * 16, J_FA = DEPTH * 8 * 16, J_MOD = DEPTH * 96;
    for (int j = F.vcu; j < J_QL + J_FA + J_MOD; j += F.G) {
        if (j < J_QL) {
            const int l = j / 128, h = (j % 128) / 16, k0 = ((j % 128) % 16) * 64;
            for (int u = F.tid; u < 128 * 64; u += 512) { const int r = u >> 6, d = u & 63; As[r * 65 + d] = F.w_uk[(((size_t)l * 128 + r) * 8 + h) * 64 + d]; }
            for (int u = F.tid; u < 64 * 64; u += 512) { const int k = u >> 6, d = u & 63; Bs[k * 65 + d] = F.w_in[((size_t)l * 1024 + k0 + k) * NCOLS_SRC + h * 64 + d]; }
            __syncthreads();
            const int k = F.tid & 63, rg = F.tid >> 6;
            bf16_t* dst = (bf16_t*)(F.ws + WS_WIN) + (size_t)l * NCOL * 1024;
            for (int rr = 0; rr < 16; ++rr) { const int r = rg * 16 + rr; float s = 0.f;
#pragma unroll 16
                for (int d = 0; d < 64; ++d) s += As[r * 65 + d] * Bs[k * 65 + d];
                dst[(size_t)(h * 128 + r) * 1024 + k0 + k] = (bf16_t)(cvt_pk_bf16(0.125f * s, 0.f) & 0xffffu); }
            __syncthreads();
        } else if (j < J_QL + J_FA) {
            const int jj = j - J_QL; const int l = jj / 128, h = (jj % 128) / 16, n0 = ((jj % 128) % 16) * 64;
            for (int u = F.tid; u < 128 * 64; u += 512) { const int r = u >> 6, d = u & 63; As[r * 65 + d] = F.w_uv[(((size_t)l * 128 + r) * 8 + h) * 64 + d]; }
            for (int u = F.tid; u < 64 * 64; u += 512) { const int d = u >> 6, n = u & 63; Bs[d * 65 + n] = F.w_a_out[((size_t)l * 512 + h * 64 + d) * 1024 + n0 + n]; }
            __syncthreads();
            const int r = F.tid & 127, ng = F.tid >> 7;
            bf16_t* dst = (bf16_t*)(F.ws + WS_WFA) + (size_t)l * 1024 * 1024;
            for (int nn = 0; nn < 16; ++nn) { const int n = ng * 16 + nn; float s = 0.f;
#pragma unroll 16
                for (int d = 0; d < 64; ++d) s += As[r * 65 + d] * Bs[d * 65 + n];
                dst[(size_t)(n0 + n) * 1024 + h * 128 + r] = (bf16_t)(cvt_pk_bf16(s, 0.f) & 0xffffu); }
            __syncthreads();
        } else {
            const int jj = j - J_QL - J_FA; const int l = jj / 96, cg = jj % 96;
            LAS float* sc = (LAS float*)F.lds;
            LAS float* part = (LAS float*)(F.lds + 32768);
            for (int u = F.tid; u < 8 * 1024; u += 512) { const float v = F.c[u]; sc[u] = v * sigmoidf_(v); }
            __syncthreads();
            const int col = F.tid & 63, ks = F.tid >> 6;
            float a[8];
#pragma unroll
            for (int b = 0; b < 8; ++b) a[b] = 0.f;
            const float* wp = F.w_ada + ((size_t)l * 1024 + ks * 128) * 6144 + cg * 64 + col;
            for (int k = 0; k < 128; ++k) { const float w = wp[(size_t)k * 6144];
#pragma unroll
                for (int b = 0; b < 8; ++b) a[b] += sc[b * 1024 + ks * 128 + k] * w; }
#pragma unroll
            for (int b = 0; b < 8; ++b) part[(ks * 8 + b) * 64 + col] = a[b];
            __syncthreads();
            { const int b = F.tid >> 6; float s = F.b_ada[(size_t)l * 6144 + cg * 64 + col];
#pragma unroll
              for (int k2 = 0; k2 < 8; ++k2) s += part[(k2 * 8 + b) * 64 + col];
              ((float*)(F.ws + WS_MOD))[((size_t)l * 8 + b) * 6144 + cg * 64 + col] = s; }
            __syncthreads();
        }
    }
}

DI void load_row(const float* p, int lane, f32x4 (&v)[4]) {
#pragma unroll
    for (int j = 0; j < 4; ++j) v[j] = *((const GAS f32x4*)p + lane + 64 * j);
}
DI void ln_stats(const f32x4 (&v)[4], float& mean, float& rstd) {
    float s = 0.f;
#pragma unroll
    for (int j = 0; j < 4; ++j) s += (v[j].x + v[j].y) + (v[j].z + v[j].w);
    mean = wave_sum(s) * (1.f / DM); float s2 = 0.f;
#pragma unroll
    for (int j = 0; j < 4; ++j) { const f32x4 d = v[j] - mean; s2 += (d.x * d.x + d.y * d.y) + (d.z * d.z + d.w * d.w); }
    rstd = 1.f / sqrtf(wave_sum(s2) * (1.f / DM) + LN_EPS);
}
DI void modulate_store(const f32x4 (&v)[4], const float* shift, const float* scale, bf16_t* orow, int lane) {
    float mean, rstd; ln_stats(v, mean, rstd);
#pragma unroll
    for (int j = 0; j < 4; ++j) {
        const f32x4 sh = *((const GAS f32x4*)shift + lane + 64 * j), sc = *((const GAS f32x4*)scale + lane + 64 * j);
        const f32x4 o = (v[j] - mean) * rstd * (sc + 1.0f) + sh;
        u32x2 w; w.x = cvt_pk_bf16(o.x, o.y); w.y = cvt_pk_bf16(o.z, o.w);
        *((GAS u32x2*)orow + lane + 64 * j) = w;
    }
}

struct DenseSched {
    int nM, nN, nwg, G, c, K; const char* Bt;
    DI void init(int M, int N, int K_, const bf16_t* Bt_, int G_, int c_) { nM = M / 256; nN = N / 256; nwg = nM * nN; G = G_; c = c_; K = K_; Bt = (const char*)Bt_; }
    DI bool next(int i, pg8::Unit& u) const {
        const long L = (long)i * G + c; if (L >= nwg) return false;
        int wgid = (int)L; { const int q = nwg / 8, r = nwg % 8, xcd = wgid % 8, off = wgid / 8; wgid = (xcd < r ? xcd * (q + 1) : r * (q + 1) + (xcd - r) * q) + off; }
        const int nig = 8 * nN, gid = wgid / nig, fm = gid * 8, gsz = (nM - fm) < 8 ? (nM - fm) : 8;
        u.pm = fm + ((wgid % nig) % gsz); u.pn = (wgid % nig) / gsz; u.aux = 0; return true;
    }
    DI unsigned a_row_off(const pg8::Unit& u, int row) const { return (unsigned)(u.pm * 256 + row) * (unsigned)(K * 2); }
    DI const char* b_tile(const pg8::Unit& u) const { return Bt + (size_t)__builtin_amdgcn_readfirstlane(u.pn) * 256 * K * 2; }
};
struct MoeSched {
    const LAS int* tstart; const LAS int* cnt; int NCT, ntiles, G, c; const char* Bt; const unsigned* list; bool gather;
    DI bool next(int i, pg8::Unit& u) const {
        const long L = (long)i * G + c; if (L >= (long)ntiles * NCT) return false;
        const int gt = (int)(L / NCT), ct = (int)(L % NCT);
        int e = 0;
#pragma unroll 1
        for (int k = 1; k < NEXP; ++k) e += (tstart[k] <= gt) ? 1 : 0;
        u.pm = __builtin_amdgcn_readfirstlane(gt); u.pn = __builtin_amdgcn_readfirstlane(ct); u.aux = __builtin_amdgcn_readfirstlane(e); return true;
    }
    DI unsigned a_row_off(const pg8::Unit& u, int row) const {
        if (!gather) return (unsigned)(u.pm * 256 + row) * 2048u;
        const int lr = (u.pm - tstart[u.aux]) * 256 + row;
        unsigned tok = 0u;
        if (lr < cnt[u.aux]) tok = list[(size_t)u.aux * NTOK + lr] >> 2;
        return tok * 2048u;
    }
    DI const char* b_tile(const pg8::Unit& u) const { return Bt + ((size_t)__builtin_amdgcn_readfirstlane(u.aux * NCT + u.pn)) * 256 * 1024 * 2; }
};

#define EPI_ROWS(...) _Pragma("unroll") for (int ai = 0; ai < 2; ++ai) _Pragma("unroll") for (int m = 0; m < 4; ++m) { const int row = u.pm * 256 + ai * 128 + wr * 64 + m * 16 + fr; \
        _Pragma("unroll") for (int bj = 0; bj < 2; ++bj) { const int col = u.pn * 256 + bj * 128 + wc * 32 + 8 * fq; const f32x4 v0 = acc[ai][bj][m][0], v1 = acc[ai][bj][m][1]; __VA_ARGS__ } asm volatile("" ::: "memory"); }
DI u32x4 pack8(const f32x4 a, const f32x4 b) { u32x4 w; w.x = cvt_pk_bf16(a[0], a[1]); w.y = cvt_pk_bf16(a[2], a[3]); w.z = cvt_pk_bf16(b[0], b[1]); w.w = cvt_pk_bf16(b[2], b[3]); return w; }
DI void unpack8(const u32x4 w, f32x4& a, f32x4& b) { a = (f32x4){bf_lo(w.x), bf_hi(w.x), bf_lo(w.y), bf_hi(w.y)}; b = (f32x4){bf_lo(w.z), bf_hi(w.z), bf_lo(w.w), bf_hi(w.w)}; }

struct EpiInProj {
    bf16_t* P; float* MISC;
    DI void operator()(const f32x4 (&acc)[2][2][4][2], const pg8::Unit& u, int wr, int wc, int fr, int fq) const {
        const int pn = u.pn;
        if (pn == 4) {
            EPI_ROWS( float* o = MISC + (size_t)row * 256 + (col - PC_MISC); *(f32x4*)o = v0; *(f32x4*)(o + 4) = v1; )
        } else if (pn >= 12) {
            EPI_ROWS( f32x4 a, b;
                _Pragma("unroll") for (int q = 0; q < 4; ++q) { a[q] = sigmoidf_(v0[q]); b[q] = sigmoidf_(v1[q]); }
                *(u32x4*)(P + (size_t)row * NCOL + col) = pack8(a, b); )
        } else {
            const float sc = (pn == 6 || pn == 7) ? SB_QSCALE : 1.0f;
            EPI_ROWS( *(u32x4*)(P + (size_t)row * NCOL + col) = pack8(v0 * sc, v1 * sc); )
        }
    }
};
struct EpiMergeA {
    const bf16_t* P; bf16_t* T;
    DI void operator()(const f32x4 (&acc)[2][2][4][2], const pg8::Unit& u, int wr, int wc, int fr, int fq) const {
        EPI_ROWS( f32x4 ga, gb; unpack8(*(const u32x4*)(P + (size_t)row * NCOL + PC_GA + col), ga, gb);
            *(u32x4*)(T + (size_t)row * DM + col) = pack8(v0 * ga, v1 * gb); )
    }
};
struct EpiMergeB {
    const bf16_t* P; const bf16_t* T; bf16_t* MG;
    DI void operator()(const f32x4 (&acc)[2][2][4][2], const pg8::Unit& u, int wr, int wc, int fr, int fq) const {
        EPI_ROWS( f32x4 ga, gb, ta, tb; unpack8(*(const u32x4*)(P + (size_t)row * NCOL + PC_GB + col), ga, gb); unpack8(*(const u32x4*)(T + (size_t)row * DM + col), ta, tb);
            *(u32x4*)(MG + (size_t)row * DM + col) = pack8(ta + v0 * ga, tb + v1 * gb); )
    }
};
struct EpiWo {
    const float* X; const float* gate; float* Z;
    DI void operator()(const f32x4 (&acc)[2][2][4][2], const pg8::Unit& u, int wr, int wc, int fr, int fq) const {
        EPI_ROWS( const float* g = gate + (size_t)(row / SEQ) * 6144 + col; const float* xp = X + (size_t)row * DM + col; float* zp = Z + (size_t)row * DM + col;
            const f32x4 g0 = *(const f32x4*)g, g1 = *(const f32x4*)(g + 4), x0 = *(const f32x4*)xp, x1 = *(const f32x4*)(xp + 4);
            *(f32x4*)zp = x0 * DN_ALPHA + g0 * v0; *(f32x4*)(zp + 4) = x1 * DN_ALPHA + g1 * v1; )
    }
};
struct EpiGateUp {
    const float* b_gu; bf16_t* ACT;
    DI void operator()(const f32x4 (&acc)[2][2][4][2], const pg8::Unit& u, int wr, int wc, int fr, int fq) const {
        const int hc = u.pn * 128 + wc * 32 + 8 * fq;
        const float* ba = b_gu + (size_t)u.aux * 2048 + hc; const float* bu = ba + 1024;
        const f32x4 ba0 = *(const f32x4*)ba, ba1 = *(const f32x4*)(ba + 4), bu0 = *(const f32x4*)bu, bu1 = *(const f32x4*)(bu + 4);
#pragma unroll
        for (int ai = 0; ai < 2; ++ai)
#pragma unroll
            for (int m = 0; m < 4; ++m) { const int row = u.pm * 256 + ai * 128 + wr * 64 + m * 16 + fr;
                f32x4 r0, r1;
#pragma unroll
                for (int q = 0; q < 4; ++q) {
                    float a = fminf(acc[ai][0][m][0][q] + ba0[q], 7.0f), uu = fminf(fmaxf(acc[ai][1][m][0][q] + bu0[q], -7.0f), 7.0f);
                    r0[q] = (uu + 1.0f) * a * sigmoidf_(1.702f * a);
                    a = fminf(acc[ai][0][m][1][q] + ba1[q], 7.0f); uu = fminf(fmaxf(acc[ai][1][m][1][q] + bu1[q], -7.0f), 7.0f);
                    r1[q] = (uu + 1.0f) * a * sigmoidf_(1.702f * a); }
                *(u32x4*)(ACT + (size_t)row * DEXP + hc) = pack8(r0, r1); }
    }
};
struct EpiDown {
    const float* b_dn; const unsigned* list; const float* gate; bf16_t* YS; const LAS int* tstart; const LAS int* cnt;
    DI void operator()(const f32x4 (&acc)[2][2][4][2], const pg8::Unit& u, int wr, int wc, int fr, int fq) const {
        const int e = u.aux, lbase = (u.pm - tstart[e]) * 256, n = cnt[e];
#pragma unroll
        for (int ai = 0; ai < 2; ++ai)
#pragma unroll
            for (int m = 0; m < 4; ++m) { const int lr = lbase + ai * 128 + wr * 64 + m * 16 + fr;
                if (lr < n) { const unsigned ent = list[(size_t)e * NTOK + lr]; const float g = gate[ent];
#pragma unroll
                    for (int bj = 0; bj < 2; ++bj) { const int col = u.pn * 256 + bj * 128 + wc * 32 + 8 * fq; const float* bp = b_dn + (size_t)e * DM + col;
                        const f32x4 b0 = *(const f32x4*)bp, b1 = *(const f32x4*)(bp + 4);
                        *(u32x4*)(YS + (size_t)ent * DM + col) = pack8((acc[ai][bj][m][0] + b0) * g, (acc[ai][bj][m][1] + b1) * g); } } }
    }
};

DI void phase_lnmod0(Ctx& F) {
    const int gw = F.vcu * 8 + F.wave, NGW = F.G * 8;
    const float* mod = (const float*)(F.ws + WS_MOD);
    bf16_t* H = (bf16_t*)(F.ws + WS_H);
    for (int m = gw; m < NTOK; m += NGW) {
        f32x4 v[4]; load_row(F.x + (size_t)m * DM, F.lane, v);
        const float* mb = mod + (size_t)(m / SEQ) * 6144;
        modulate_store(v, mb, mb + DM, H + (size_t)m * DM, F.lane);
    }
}
DI void phase_misc(Ctx& F, int l) {
    const int gw = F.vcu * 8 + F.wave, NGW = F.G * 8;
    const float* MISC = (const float*)(F.ws + WS_MISC);
    bf16_t* CKV = (bf16_t*)(F.ws + WS_CKV); bf16_t* KIDX = (bf16_t*)(F.ws + WS_KIDX); float* WIDX = (float*)(F.ws + WS_WIDX);
    const float idx_scale = 0.5f * 0.125f;
    f32x4 g = (f32x4){0.f, 0.f, 0.f, 0.f};
    if (F.lane < 32) g = *((const GAS f32x4*)(F.g_kv + (size_t)l * KVR) + F.lane);
    for (int m = gw; m < NTOK; m += NGW) {
        const f32x4 v = *((const GAS f32x4*)(MISC + (size_t)m * 256) + F.lane);
        float s = (F.lane < 32) ? (v.x * v.x + v.y * v.y) + (v.z * v.z + v.w * v.w) : 0.f;
        s = wave_sum(s);
        const float r = 1.0f / sqrtf(s * (1.f / KVR) + RMS_EPS);
        if (F.lane < 32) { u32x2 w; w.x = cvt_pk_bf16(v.x * r * g.x, v.y * r * g.y); w.y = cvt_pk_bf16(v.z * r * g.z, v.w * r * g.w); *((GAS u32x2*)(CKV + (size_t)m * KVR) + F.lane) = w; }
        else if (F.lane < 48) { u32x2 w; w.x = cvt_pk_bf16(v.x, v.y); w.y = cvt_pk_bf16(v.z, v.w); *((GAS u32x2*)(KIDX + (size_t)m * IDXD) + (F.lane - 32)) = w; }
        else if (F.lane == 48) { *((GAS f32x4*)(WIDX + (size_t)m * 4)) = v * idx_scale; }
    }
}

DI void phase_ln_router(Ctx& F, int l) {
    const float* mod = (const float*)(F.ws + WS_MOD) + (size_t)l * 8 * 6144;
    float* ZX = (float*)(F.ws + WS_ZX); bf16_t* H = (bf16_t*)(F.ws + WS_H);
    const float* g1 = F.ln1_g + (size_t)l * DM; const float* b1 = F.ln1_b + (size_t)l * DM;
    const float* wr = F.w_router + (size_t)l * DM * NEXP; const float* br = F.b_router + (size_t)l * NEXP;
    LAS float* tile = (LAS float*)F.lds;
    LAS float* part = (LAS float*)F.lds;
    LAS float* logit = (LAS float*)(F.lds + 135168);
    LAS unsigned* rec_e = (LAS unsigned*)(F.lds + 140288);
    LAS float* rec_g = (LAS float*)(F.lds + 140288 + 8192);
    LAS unsigned* lcnt = (LAS unsigned*)(F.lds + 140288 + 16384);
    unsigned* list = (unsigned*)(F.ws + WS_LIST); float* gate = (float*)(F.ws + WS_GATE);
    const int lane = F.lane, w = F.wave, hi = lane >> 5, r32 = lane & 31;
    const float* wrl = wr + (size_t)(128 * w + 4 * hi) * NEXP + r32;
    if (F.tid < 32) lcnt[F.tid] = 0u;
    __syncthreads();
    const int ntile = NTOK / 32; int nloc = 0;
    for (int tI = F.vcu; tI < ntile; tI += F.G, ++nloc) {
        const int tok0 = tI * 32;
#pragma unroll 1
        for (int rr = 0; rr < 4; ++rr) {
            const int row = tok0 + 4 * w + rr; const int b = row / SEQ;
            f32x4 v[4]; load_row(ZX + (size_t)row * DM, lane, v);
            float mean, rstd; ln_stats(v, mean, rstd);
#pragma unroll
            for (int j = 0; j < 4; ++j) { const f32x4 gg = *((const GAS f32x4*)g1 + lane + 64 * j), bb = *((const GAS f32x4*)b1 + lane + 64 * j);
                v[j] = (v[j] - mean) * rstd * gg + bb; *((GAS f32x4*)(ZX + (size_t)row * DM) + lane + 64 * j) = v[j]; }
            ln_stats(v, mean, rstd);
            const float* sh = mod + (size_t)b * 6144 + 3 * DM; const float* sc = sh + DM;
#pragma unroll
            for (int j = 0; j < 4; ++j) { const f32x4 s4 = *((const GAS f32x4*)sh + lane + 64 * j), c4 = *((const GAS f32x4*)sc + lane + 64 * j);
                const f32x4 o = (v[j] - mean) * rstd * (c4 + 1.0f) + s4;
                u32x2 pk; pk.x = cvt_pk_bf16(o.x, o.y); pk.y = cvt_pk_bf16(o.z, o.w);
                *((GAS u32x2*)(H + (size_t)row * DM) + lane + 64 * j) = pk;
                *(LAS f32x4*)(tile + (4 * w + rr) * 1028 + 4 * lane + 256 * j) = o; }
        }
        __syncthreads();
        float bw[64];
#pragma unroll
        for (int s = 0; s < 64; ++s) bw[s] = wrl[(8 * (s >> 2) + (s & 3)) * NEXP];
        f32x16 acc;
#pragma unroll
        for (int i = 0; i < 16; ++i) acc[i] = 0.f;
#pragma unroll
        for (int s4 = 0; s4 < 16; ++s4) {
            const f32x4 a4 = *(const LAS f32x4*)(tile + r32 * 1028 + 128 * w + 8 * s4 + 4 * hi);
#pragma unroll
            for (int q = 0; q < 4; ++q) acc = __builtin_amdgcn_mfma_f32_32x32x2f32(a4[q], bw[4 * s4 + q], acc, 0, 0, 0);
        }
        __syncthreads();
#pragma unroll
        for (int i = 0; i < 16; ++i) part[(w * 32 + ((i & 3) + 8 * (i >> 2) + 4 * hi)) * 33 + r32] = acc[i];
        __syncthreads();
        for (int u = F.tid; u < 1024; u += 512) { const int t = u >> 5, e = u & 31; float s = br[e];
#pragma unroll
            for (int k = 0; k < 8; ++k) s += part[(k * 32 + t) * 33 + e];
            logit[t * 33 + e] = s; }
        __syncthreads();
        if (F.tid < 32) {
            const int t = F.tid; float tv[4]; int te[4]; unsigned used = 0u;
#pragma unroll
            for (int k = 0; k < 4; ++k) { float best = -INFINITY; int be = 0;
                for (int e = 0; e < 32; ++e) { const float v = logit[t * 33 + e]; if (!((used >> e) & 1u) && v > best) { best = v; be = e; } }
                tv[k] = best; te[k] = be; used |= 1u << be; }
            const float e1 = __expf(tv[1] - tv[0]), e2 = __expf(tv[2] - tv[0]), e3 = __expf(tv[3] - tv[0]); const float inv = 1.0f / (1.0f + e1 + e2 + e3);
            const float gs[4] = {inv, e1 * inv, e2 * inv, e3 * inv};
#pragma unroll
            for (int k = 0; k < 4; ++k) { const unsigned lr = atomicAdd((unsigned*)&lcnt[te[k]], 1u); rec_e[(nloc * 32 + t) * 4 + k] = (unsigned)te[k] | (lr << 8); rec_g[(nloc * 32 + t) * 4 + k] = gs[k]; }
        }
        __syncthreads();
    }
    if (F.tid < 32) lcnt[32 + F.tid] = __hip_atomic_fetch_add((unsigned*)(F.ctl + CW_CNT + l * NEXP + F.tid), lcnt[F.tid], RLX_AGENT);
    __syncthreads();
    for (int u = F.tid; u < nloc * 128; u += 512) {
        const int tl = u >> 2, k = u & 3; const int tok = (F.vcu + (tl >> 5) * F.G) * 32 + (tl & 31);
        const unsigned re = rec_e[u]; const unsigned e = re & 255u, lr = re >> 8;
        list[(size_t)e * NTOK + lcnt[32 + e] + lr] = (unsigned)tok * 4u + (unsigned)k;
        gate[(size_t)tok * 4 + k] = rec_g[u];
    }
    __syncthreads();
}

DI void phase_final(Ctx& F, int l, float* xout, bool has_next) {
    const int gw = F.vcu * 8 + F.wave, NGW = F.G * 8;
    const float* mod = (const float*)(F.ws + WS_MOD) + (size_t)l * 8 * 6144;
    const float* modn = (const float*)(F.ws + WS_MOD) + (size_t)(l + 1) * 8 * 6144;
    const float* X1 = (const float*)(F.ws + WS_ZX); const bf16_t* YS = (const bf16_t*)(F.ws + WS_YS); bf16_t* H = (bf16_t*)(F.ws + WS_H);
    const float* g2 = F.ln2_g + (size_t)l * DM; const float* b2 = F.ln2_b + (size_t)l * DM;
    for (int m = gw; m < NTOK; m += NGW) {
        const int b = m / SEQ; f32x4 v[4]; load_row(X1 + (size_t)m * DM, F.lane, v);
        const float* gt = mod + (size_t)b * 6144 + 5 * DM;
#pragma unroll
        for (int j = 0; j < 4; ++j) { f32x4 y = (f32x4){0.f, 0.f, 0.f, 0.f};
#pragma unroll
            for (int k = 0; k < 4; ++k) { const u32x2 w = *((const GAS u32x2*)(YS + ((size_t)m * 4 + k) * DM) + F.lane + 64 * j); y += (f32x4){bf_lo(w.x), bf_hi(w.x), bf_lo(w.y), bf_hi(w.y)}; }
            const f32x4 g4 = *((const GAS f32x4*)gt + F.lane + 64 * j);
            v[j] = v[j] * DN_ALPHA + g4 * y; }
        float mean, rstd; ln_stats(v, mean, rstd);
#pragma unroll
        for (int j = 0; j < 4; ++j) { const f32x4 gg = *((const GAS f32x4*)g2 + F.lane + 64 * j), bb = *((const GAS f32x4*)b2 + F.lane + 64 * j);
            v[j] = (v[j] - mean) * rstd * gg + bb; *((GAS f32x4*)(xout + (size_t)m * DM) + F.lane + 64 * j) = v[j]; }
        if (has_next) { const float* mb = modn + (size_t)b * 6144; modulate_store(v, mb, mb + DM, H + (size_t)m * DM, F.lane); }
    }
}

typedef LAS const char* lds_cptr;
typedef short v4i16_t __attribute__((ext_vector_type(4)));
DI s16x4 vtr(lds_cptr p) { return __builtin_bit_cast(s16x4, __builtin_amdgcn_ds_read_tr16_b64_v4i16((LAS v4i16_t*)p)); }
DI int crow(int r, int hi) { return (r & 3) + 8 * (r >> 2) + 4 * hi; }
DI float pair_sum(float v) { auto rr = __builtin_amdgcn_permlane32_swap(__float_as_uint(v), __float_as_uint(v), false, false); return __uint_as_float(rr[0]) + __uint_as_float(rr[1]); }

DI void phase_sb(Ctx& F) {
    const bf16_t* P = (const bf16_t*)(F.ws + WS_P); bf16_t* OB = (bf16_t*)(F.ws + WS_OB);
    const int lane = F.lane, r32 = lane & 31, hi = lane >> 5;
    const int gw = F.vcu * 8 + F.wave, NGW = F.G * 8;
    LAS char* vs = (LAS char*)(F.lds + F.wave * 8192);
    const lds_cptr vp0 = (lds_cptr)vs + ((lane >> 4) & 1) * 32 + (lane & 3) * 8 + (4 * hi + ((lane & 15) >> 2)) * 64;
    for (int u = gw; u < NB * NHB * (SEQ / 32); u += NGW) {
        const int qblk = u & 255, h = (u >> 8) & 7, b = u >> 11, t0 = qblk * 32, t = t0 + r32;
        const size_t rowb = (size_t)b * SEQ;
        bf16x8 qr[4];
        { const bf16_t* Qp = P + (rowb + t) * NCOL + PC_QB + h * 64 + hi * 8;
#pragma unroll
          for (int d0 = 0; d0 < 4; ++d0) qr[d0] = *(const bf16x8*)(Qp + d0 * 16); }
        f32x16 o[2];
#pragma unroll
        for (int i = 0; i < 16; ++i) { o[0][i] = 0.f; o[1][i] = 0.f; }
        float carry = 0.f;
        for (int j = t0 >> 6; j >= 0; --j) {
            const bf16_t* Kp = P + (rowb + 64 * j + r32) * NCOL + PC_KB + h * 64 + hi * 8;
            bf16x8 k0[4], k1[4];
#pragma unroll
            for (int d0 = 0; d0 < 4; ++d0) { k0[d0] = *(const bf16x8*)(Kp + d0 * 16); k1[d0] = *(const bf16x8*)(Kp + (size_t)32 * NCOL + d0 * 16); }
            LDS_WAIT();
#pragma unroll
            for (int i = 0; i < 8; ++i) { const int row = 16 * (i & 3) + (lane >> 2), col = (i >> 2) * 32 + (lane & 3) * 8;
                const u32x4 v = *(const u32x4*)(P + (rowb + 64 * j + row) * NCOL + PC_VB + h * 64 + col);
                *(LAS u32x4*)(vs + i * 1024 + lane * 16) = v; }
            f32x16 p0, p1;
#pragma unroll
            for (int i = 0; i < 16; ++i) { p0[i] = 0.f; p1[i] = 0.f; }
#pragma unroll
            for (int d0 = 0; d0 < 4; ++d0) { p0 = __builtin_amdgcn_mfma_f32_32x32x16_bf16(k0[d0], qr[d0], p0, 0, 0, 0); p1 = __builtin_amdgcn_mfma_f32_32x32x16_bf16(k1[d0], qr[d0], p1, 0, 0, 0); }
            const bool diag = (64 * j + 63 >= t0);
            float L0[16], L1[16];
#pragma unroll
            for (int r = 0; r < 16; ++r) {
                const int s0 = 64 * j + crow(r, hi);
                float a = fmaxf(p0[r], 0.f) + fast_log2(1.0f + fast_exp2(-fabsf(p0[r])));
                float c = fmaxf(p1[r], 0.f) + fast_log2(1.0f + fast_exp2(-fabsf(p1[r])));
                if (diag) { if (s0 >= t) a = 0.f; if (s0 + 32 >= t) c = 0.f; }
                L0[r] = a; L1[r] = c; }
            float W[8], T[8];
#pragma unroll
            for (int g = 0; g < 4; ++g) { T[g] = (L0[4 * g] + L0[4 * g + 1]) + (L0[4 * g + 2] + L0[4 * g + 3]); T[4 + g] = (L1[4 * g] + L1[4 * g + 1]) + (L1[4 * g + 2] + L1[4 * g + 3]); }
#pragma unroll
            for (int g = 0; g < 8; ++g) W[g] = pair_sum(T[g]);
            float suf = carry;
#pragma unroll
            for (int g = 7; g >= 0; --g) {
                float off = suf + ((hi == 0) ? (W[g] - T[g]) : 0.f);
                if (g >= 4) {
#pragma unroll
                    for (int q = 3; q >= 0; --q) { const int r = 4 * (g - 4) + q; off += L1[r]; float a = fast_exp2(p1[r] - off); if (diag && (64 * j + 32 + crow(r, hi) >= t)) a = 0.f; p1[r] = a; }
                } else {
#pragma unroll
                    for (int q = 3; q >= 0; --q) { const int r = 4 * g + q; off += L0[r]; float a = fast_exp2(p0[r] - off); if (diag && (64 * j + crow(r, hi) >= t)) a = 0.f; p0[r] = a; }
                }
                suf += W[g];
            }
            carry = suf;
            u32x4 pw[4];
#pragma unroll
            for (int q = 0; q < 4; ++q) { pw[0][q] = cvt_pk_bf16(p0[2 * q], p0[2 * q + 1]); pw[1][q] = cvt_pk_bf16(p0[8 + 2 * q], p0[8 + 2 * q + 1]); pw[2][q] = cvt_pk_bf16(p1[2 * q], p1[2 * q + 1]); pw[3][q] = cvt_pk_bf16(p1[8 + 2 * q], p1[8 + 2 * q + 1]); }
#pragma unroll
            for (int d0 = 0; d0 < 2; ++d0)
#pragma unroll
                for (int ks = 0; ks < 4; ++ks) {
                    const s16x4 lo = vtr(vp0 + d0 * 4096 + ks * 1024), hv = vtr(vp0 + d0 * 4096 + ks * 1024 + 512);
                    const bf16x8 vf = (bf16x8){lo[0], lo[1], lo[2], lo[3], hv[0], hv[1], hv[2], hv[3]};
                    o[d0] = __builtin_amdgcn_mfma_f32_32x32x16_bf16(__builtin_bit_cast(bf16x8, pw[ks]), vf, o[d0], 0, 0, 0); }
            if (!__any(carry < SB_STOP)) break;
        }
        bf16_t* Op = OB + (rowb + t0) * 512 + h * 64 + r32;
#pragma unroll
        for (int i = 0; i < 16; ++i) { const int row = crow(i, hi);
            Op[(size_t)row * 512] = (bf16_t)(cvt_pk_bf16(o[0][i], 0.f) & 0xffffu); Op[(size_t)row * 512 + 32] = (bf16_t)(cvt_pk_bf16(o[1][i], 0.f) & 0xffffu); }
    }
    LDS_WAIT();
}

constexpr int DS_HIST = 0;
constexpr int DS_STAGE = 0;
constexpr int DS_SEL = 131200;
constexpr int DS_SELCNT = DS_SEL + 16384;
constexpr int DS_STATE = DS_SELCNT + 128;
constexpr int DS_CSUM = DS_STATE + 6 * 128;
constexpr int DS_LUT = DS_CSUM + 2048;
constexpr int DS_END = DS_LUT + 129 * 8 * 4;
static_assert(DS_END <= SCH_OFF, "DSA LDS map");
constexpr int STG_ROW = 272, STG_WAVE = 32 * STG_ROW;
constexpr int DS_BMAP = 73728;
static_assert(8 * STG_WAVE <= DS_BMAP && DS_BMAP + 32768 <= DS_SEL, "bitmap placement");

DI unsigned f2key(float f) { const unsigned u = __float_as_uint(f + 0.0f); return u ^ ((unsigned)((int)u >> 31) | 0x80000000u); }

struct DsaQ {
    bf16x8 qf[4][4];
    float w[4];
};

template <int MODE>
DI void dsa_pass(Ctx& F, const DsaQ& Q, const bf16_t* KIDX, size_t rowb, int qb, unsigned pre, unsigned tieB, unsigned tieR, unsigned need) {
    const int lane = F.lane, r32 = lane & 31, hi = lane >> 5;
    LAS unsigned* hist = (LAS unsigned*)(F.lds + DS_HIST) + r32 * 1025;
    LAS unsigned* bmap = (LAS unsigned*)(F.lds + DS_BMAP) + r32 * 256;
    for (int kt = F.wave; kt <= qb; kt += 8) {
        const bf16_t* Kp = KIDX + (rowb + 32 * kt + r32) * IDXD + hi * 8;
        bf16x8 kf[4];
#pragma unroll
        for (int s = 0; s < 4; ++s) kf[s] = *(const bf16x8*)(Kp + s * 16);
        f32x16 sc;
#pragma unroll
        for (int i = 0; i < 16; ++i) sc[i] = 0.f;
#pragma unroll
        for (int h = 0; h < 4; ++h) {
            f32x16 d;
#pragma unroll
            for (int i = 0; i < 16; ++i) d[i] = 0.f;
#pragma unroll
            for (int s = 0; s < 4; ++s) d = __builtin_amdgcn_mfma_f32_32x32x16_bf16(kf[s], Q.qf[h][s], d, 0, 0, 0);
#pragma unroll
            for (int i = 0; i < 16; ++i) sc[i] = __builtin_fmaf(fmaxf(d[i], 0.f), Q.w[h], sc[i]);
        }
        const bool diag = (kt == qb);
#pragma unroll
        for (int g = 0; g < 4; ++g) {
            unsigned ord = 0u;
#pragma unroll
            for (int q = 0; q < 4; ++q) {
                const int i = 4 * g + q; const int kr = crow(i, hi);
                const bool valid = !diag || (kr <= r32);
                const unsigned key = f2key(sc[i]); const unsigned idx = (unsigned)(32 * kt + kr);
                if (MODE == 0) { if (valid) { const unsigned bin = key >> 21; __hip_atomic_fetch_add(hist + (bin >> 1), 1u << ((bin & 1u) * 16u), __ATOMIC_RELAXED, __HIP_MEMORY_SCOPE_WORKGROUP); } }
                else if (MODE == 1) { if (valid && (key >> 21) == pre) { const unsigned bin = (key >> 10) & 2047u; __hip_atomic_fetch_add(hist + (bin >> 1), 1u << ((bin & 1u) * 16u), __ATOMIC_RELAXED, __HIP_MEMORY_SCOPE_WORKGROUP); } }
                else if (MODE == 2) { if (valid && (key >> 10) == pre) { const unsigned bin = key & 1023u; __hip_atomic_fetch_add(hist + (bin >> 1), 1u << ((bin & 1u) * 16u), __ATOMIC_RELAXED, __HIP_MEMORY_SCOPE_WORKGROUP); } }
                else if (MODE == 3) { if (valid && need && key == pre) { const unsigned bin = idx >> 2; __hip_atomic_fetch_add(hist + (bin >> 1), 1u << ((bin & 1u) * 16u), __ATOMIC_RELAXED, __HIP_MEMORY_SCOPE_WORKGROUP); } }
                else {
                    const bool tie = valid && (key == pre);
                    const unsigned grp = idx >> 2;
                    const bool take = valid && ((key > pre) || (tie && (grp < tieB || (grp == tieB && ord < tieR))));
                    if (tie) ++ord;
                    if (take) __hip_atomic_fetch_or(bmap + (idx >> 5), 1u << (idx & 31u), __ATOMIC_RELAXED, __HIP_MEMORY_SCOPE_WORKGROUP);
                }
            }
        }
    }
}

template <int MODE>
DI void dsa_scan(Ctx& F) {
    LAS unsigned* hist = (LAS unsigned*)(F.lds + DS_HIST);
    LAS unsigned* st = (LAS unsigned*)(F.lds + DS_STATE);
    LAS unsigned* csum = (LAS unsigned*)(F.lds + DS_CSUM);
    const int q = F.tid >> 4, j = F.tid & 15;
    LAS unsigned* hw = hist + q * 1025 + 64 * j;
    __syncthreads();
    unsigned s = 0u;
    for (int w = 0; w < 64; ++w) { const unsigned v = hw[w]; s += (v & 0xffffu) + (v >> 16); }
    csum[q * 16 + j] = s;
    __syncthreads();
    const unsigned rank = st[32 + q];
    const bool active = (MODE != 3) || (st[128 + q] != 0u);
    unsigned before = 0u;
    if (MODE != 3) { for (int k = j + 1; k < 16; ++k) before += csum[q * 16 + k]; }
    else { for (int k = 0; k < j; ++k) before += csum[q * 16 + k]; }
    if (active && before < rank && rank <= before + s) {
        unsigned c = before, bin = 0u, cb = 0u, m = 0u; bool found = false;
        if (MODE != 3) {
            for (int w = 63; w >= 0 && !found; --w) { const unsigned v = hw[w]; const unsigned h1 = v >> 16, h0 = v & 0xffffu;
                if (c + h1 >= rank) { bin = 128u * j + 2u * w + 1u; cb = c; m = h1; found = true; }
                else { c += h1; if (c + h0 >= rank) { bin = 128u * j + 2u * w; cb = c; m = h0; found = true; } else c += h0; } }
        } else {
            for (int w = 0; w < 64 && !found; ++w) { const unsigned v = hw[w]; const unsigned h1 = v >> 16, h0 = v & 0xffffu;
                if (c + h0 >= rank) { bin = 128u * j + 2u * w; cb = c; m = h0; found = true; }
                else { c += h0; if (c + h1 >= rank) { bin = 128u * j + 2u * w + 1u; cb = c; m = h1; found = true; } else c += h1; } }
        }
        const unsigned r = rank - cb;
        if (MODE == 0) { st[q] = bin; st[32 + q] = r; }
        else if (MODE == 1) { st[q] = (st[q] << 11) | bin; st[32 + q] = r; }
        else if (MODE == 2) { st[q] = (st[q] << 10) | bin; st[32 + q] = r; const unsigned nd = (r < m) ? 1u : 0u; st[128 + q] = nd; st[64 + q] = 0x7fffffffu; st[96 + q] = 0u; if (nd) st[160] = 1u; }
        else { st[64 + q] = bin; st[96 + q] = r; }
    }
    __syncthreads();
    for (int w = 0; w < 64; ++w) hw[w] = 0u;
    if (j == 15) hw[64] = 0u;
    __syncthreads();
}

DI void dsa_attend(Ctx& F, const bf16_t* P, const bf16_t* CKV, bf16_t* OLAT, size_t rowb, int t, int qi) {
    const int lane = F.lane, hd = lane & 15, g = lane >> 4;
    LAS unsigned char* stg = F.lds + DS_STAGE + F.wave * STG_WAVE;
    const LAS unsigned short* sel = (const LAS unsigned short*)(F.lds + DS_SEL) + qi * 256;
    const LAS float* lut = (const LAS float*)(F.lds + DS_LUT);
    int cnt = (int)((const LAS unsigned*)(F.lds + DS_SELCNT))[qi]; cnt = cnt > 256 ? 256 : cnt;
    bf16x8 ql[4];
    { const bf16_t* qp = P + (rowb + t) * NCOL + PC_QLAT + (hd & 7) * 128 + 8 * g;
#pragma unroll
      for (int ks = 0; ks < 4; ++ks) { ql[ks] = *(const bf16x8*)(qp + 32 * ks); if (hd >= 8) ql[ks] = (bf16x8){0, 0, 0, 0, 0, 0, 0, 0}; } }
    f32x4 O[8];
#pragma unroll
    for (int c = 0; c < 8; ++c) O[c] = (f32x4){0.f, 0.f, 0.f, 0.f};
    float m_run = -1e30f, l_run = 0.f;
    for (int c0 = 0; c0 < cnt; c0 += 32) {
        LDS_WAIT();
#pragma unroll
        for (int i = 0; i < 8; ++i) { const int row = 4 * i + (lane >> 4); const int slot = c0 + row; const unsigned key = (slot < cnt) ? (unsigned)sel[slot] : 0u;
            const u32x4 v = *(const u32x4*)(CKV + (rowb + key) * KVR + (lane & 15) * 8);
            *(LAS u32x4*)(stg + row * STG_ROW + (lane & 15) * 16) = v; }
        f32x4 S[2];
#pragma unroll
        for (int a = 0; a < 2; ++a) { S[a] = (f32x4){0.f, 0.f, 0.f, 0.f};
#pragma unroll
            for (int ks = 0; ks < 4; ++ks) { const bf16x8 cf = *(const LAS bf16x8*)(stg + (16 * a + hd) * STG_ROW + (32 * ks + 8 * g) * 2);
                S[a] = __builtin_amdgcn_mfma_f32_16x16x32_bf16(cf, ql[ks], S[a], 0, 0, 0); } }
        float mx = -1e30f;
#pragma unroll
        for (int a = 0; a < 2; ++a)
#pragma unroll
            for (int i = 0; i < 4; ++i) { const int slot = c0 + 16 * a + 4 * g + i;
                float v = -1e30f;
                if (slot < cnt) { int dd = t - (int)sel[slot]; dd = dd < 0 ? 0 : (dd > 128 ? 128 : dd); v = S[a][i] + lut[dd * 8 + (hd & 7)]; }
                S[a][i] = v; mx = fmaxf(mx, v); }
        mx = fmaxf(mx, __shfl_xor(mx, 16)); mx = fmaxf(mx, __shfl_xor(mx, 32));
        const float m_new = fmaxf(m_run, mx);
        const float alpha = fast_exp2((m_run - m_new) * LOG2E);
        float ps = 0.f;
#pragma unroll
        for (int a = 0; a < 2; ++a)
#pragma unroll
            for (int i = 0; i < 4; ++i) { const float p = fast_exp2((S[a][i] - m_new) * LOG2E); S[a][i] = p; ps += p; }
        l_run = l_run * alpha + ps; m_run = m_new;
        float al[4];
#pragma unroll
        for (int i = 0; i < 4; ++i) al[i] = __shfl(alpha, 4 * g + i);
        u32x4 pw; pw.x = cvt_pk_bf16(S[0][0], S[0][1]); pw.y = cvt_pk_bf16(S[0][2], S[0][3]); pw.z = cvt_pk_bf16(S[1][0], S[1][1]); pw.w = cvt_pk_bf16(S[1][2], S[1][3]);
        const lds_cptr tb = (lds_cptr)stg + (4 * g + (hd >> 2)) * STG_ROW + 8 * (hd & 3);
#pragma unroll
        for (int c = 0; c < 8; ++c) {
            const s16x4 lo = vtr(tb + 32 * c), hv = vtr(tb + 16 * STG_ROW + 32 * c);
            const bf16x8 cf = (bf16x8){lo[0], lo[1], lo[2], lo[3], hv[0], hv[1], hv[2], hv[3]};
#pragma unroll
            for (int i = 0; i < 4; ++i) O[c][i] *= al[i];
            O[c] = __builtin_amdgcn_mfma_f32_16x16x32_bf16(__builtin_bit_cast(bf16x8, pw), cf, O[c], 0, 0, 0);
        }
    }
    l_run += __shfl_xor(l_run, 16); l_run += __shfl_xor(l_run, 32);
    const float inv = 1.0f / l_run;
    float iv[4];
#pragma unroll
    for (int i = 0; i < 4; ++i) iv[i] = __shfl(inv, 4 * g + i);
    if (g < 2) {
        bf16_t* op = OLAT + (rowb + t) * 1024 + hd;
#pragma unroll
        for (int c = 0; c < 8; ++c)
#pragma unroll
            for (int i = 0; i < 4; ++i) op[(4 * g + i) * 128 + 16 * c] = (bf16_t)(cvt_pk_bf16(O[c][i] * iv[i], 0.f) & 0xffffu);
    }
}

DI void phase_dsa(Ctx& F) {
    const bf16_t* P = (const bf16_t*)(F.ws + WS_P); const bf16_t* KIDX = (const bf16_t*)(F.ws + WS_KIDX); const bf16_t* CKV = (const bf16_t*)(F.ws + WS_CKV);
    const float* WIDX = (const float*)(F.ws + WS_WIDX); bf16_t* OLAT = (bf16_t*)(F.ws + WS_OLAT);
    const int lane = F.lane, r32 = lane & 31, hi = lane >> 5;
    LAS unsigned* st = (LAS unsigned*)(F.lds + DS_STATE);
    LAS unsigned* selcnt = (LAS unsigned*)(F.lds + DS_SELCNT);
    { LAS float* lut = (LAS float*)(F.lds + DS_LUT);
      for (int u = F.tid; u < 129 * 8; u += 512) { const int d = u >> 3, h = u & 7; int bk;
          if (d < 16) bk = d; else { bk = 16 + (d >= 19) + (d >= 21) + (d >= 24) + (d >= 27) + (d >= 31) + (d >= 35) + (d >= 40) + (d >= 46) + (d >= 52) + (d >= 59) + (d >= 67) + (d >= 77) + (d >= 87) + (d >= 99) + (d >= 113); }
          lut[u] = F.rel_bias[bk * 8 + h]; }
      LAS unsigned* hist = (LAS unsigned*)(F.lds + DS_HIST);
      for (int u = F.tid; u < 32 * 1025; u += 512) hist[u] = 0u; }
    __syncthreads();
    for (int pr = F.vcu; pr < NB * 128; pr += F.G) {
        const int b = pr >> 7, ii = pr & 127; const size_t rowb = (size_t)b * SEQ;
#pragma unroll 1
        for (int half = 0; half < 2; ++half) {
            const int qb = half ? (255 - ii) : ii, t0 = qb * 32;
            DsaQ Q;
            { const bf16_t* qp = P + (rowb + t0 + r32) * NCOL + PC_QIDX + hi * 8;
#pragma unroll
              for (int h = 0; h < 4; ++h)
#pragma unroll
                  for (int s = 0; s < 4; ++s) Q.qf[h][s] = *(const bf16x8*)(qp + h * 64 + s * 16);
              const f32x4 w4 = *(const f32x4*)(WIDX + (rowb + t0 + r32) * 4); Q.w[0] = w4.x; Q.w[1] = w4.y; Q.w[2] = w4.z; Q.w[3] = w4.w; }
            if (F.tid < 32) { st[F.tid] = 0u; st[32 + F.tid] = TOPK; st[64 + F.tid] = 0x7fffffffu; st[96 + F.tid] = 0u; st[128 + F.tid] = 0u; selcnt[F.tid] = 0u; }
            if (F.tid == 0) st[160] = 0u;
            __syncthreads();
            if (qb >= 8) {
                dsa_pass<0>(F, Q, KIDX, rowb, qb, 0u, 0u, 0u, 0u); dsa_scan<0>(F);
                dsa_pass<1>(F, Q, KIDX, rowb, qb, st[r32], 0u, 0u, 0u); dsa_scan<1>(F);
                dsa_pass<2>(F, Q, KIDX, rowb, qb, st[r32], 0u, 0u, 0u); dsa_scan<2>(F);
                if (st[160] != 0u) { dsa_pass<3>(F, Q, KIDX, rowb, qb, st[r32], 0u, 0u, st[128 + r32]); dsa_scan<3>(F); }
            }
            dsa_pass<4>(F, Q, KIDX, rowb, qb, st[r32], st[64 + r32], st[96 + r32], 0u);
            __syncthreads();
#pragma unroll 1
            for (int qq = 0; qq < 4; ++qq) { const int qi = 4 * F.wave + qq;
                LAS unsigned* bm = (LAS unsigned*)(F.lds + DS_BMAP) + qi * 256 + 4 * lane;
                const u32x4 wv = *(LAS u32x4*)bm; *(LAS u32x4*)bm = (u32x4){0u, 0u, 0u, 0u};
                const int c0 = __builtin_popcount(wv.x), c1 = __builtin_popcount(wv.y), c2 = __builtin_popcount(wv.z), c3 = __builtin_popcount(wv.w);
                const int tot = c0 + c1 + c2 + c3; int inc = tot;
#pragma unroll
                for (int o = 1; o < 64; o <<= 1) { const int n = __shfl_up(inc, o); if (lane >= o) inc += n; }
                int pos = inc - tot;
                LAS unsigned short* sl = (LAS unsigned short*)(F.lds + DS_SEL) + qi * 256;
                unsigned wds[4] = {wv.x, wv.y, wv.z, wv.w};
#pragma unroll
                for (int k = 0; k < 4; ++k) { unsigned m = wds[k]; while (m) { const int bit = __builtin_ctz(m); m &= m - 1u; if (pos < 256) sl[pos] = (unsigned short)(128 * lane + 32 * k + bit); ++pos; } }
                if (lane == 63) selcnt[qi] = (unsigned)inc; }
            __syncthreads();
#pragma unroll 1
            for (int qq = 0; qq < 4; ++qq) { const int qi = 4 * F.wave + qq; dsa_attend(F, P, CKV, OLAT, rowb, t0 + qi, qi); }
            LDS_WAIT();
            __syncthreads();
            { LAS unsigned* hist = (LAS unsigned*)(F.lds + DS_HIST);
              for (int u = F.tid; u < 8 * STG_WAVE / 4; u += 512) hist[u] = 0u; }
            __syncthreads();
        }
    }
}

#ifndef MK_SINGLE
#define MK_SINGLE 1
#endif
constexpr int NPHASE = 2 + 9 * DEPTH;
struct Args { const float* in[22]; float* out; unsigned char* ws; int ph_lo, ph_hi; };

typedef const __attribute__((address_space(4))) Args* KArgsPtr;
DI void ctx_load(Ctx& F, LAS unsigned char* lds) {
    const __attribute__((address_space(4))) char* ka = (const __attribute__((address_space(4))) char*)__builtin_amdgcn_kernarg_segment_ptr();
    asm volatile("" : "+s"(ka));
    KArgsPtr a = (KArgsPtr)ka;
    int t = threadIdx.x; asm volatile("" : "+v"(t));
    F.lds = lds; F.tid = t; F.lane = t & 63; F.wave = __builtin_amdgcn_readfirstlane(t >> 6);
    F.G = gridDim.x; { const int bx = blockIdx.x; F.vcu = (F.G % 8 == 0) ? (bx % 8) * (F.G / 8) + bx / 8 : bx; }
    F.x = a->in[0]; F.c = a->in[1]; F.rel_bias = a->in[2]; F.w_ada = a->in[3]; F.b_ada = a->in[4]; F.w_in = a->in[5]; F.g_kv = a->in[6]; F.w_uk = a->in[7]; F.w_uv = a->in[8];
    F.w_a_out = a->in[9]; F.w_b_out = a->in[10]; F.w_o = a->in[11]; F.ln1_g = a->in[12]; F.ln1_b = a->in[13]; F.w_router = a->in[14]; F.b_router = a->in[15];
    F.w_gu = a->in[16]; F.b_gu = a->in[17]; F.w_dn = a->in[18]; F.b_dn = a->in[19]; F.ln2_g = a->in[20]; F.ln2_b = a->in[21];
    F.out = a->out; F.ws = a->ws; F.ctl = (gu32*)(a->ws + WS_CTL);
}

__global__ void __launch_bounds__(512, 2) mega_fwd(Args args) {
    extern __shared__ __attribute__((aligned(16))) unsigned char lds_raw[];
    LAS unsigned char* const lds = (LAS unsigned char*)lds_raw;
    for (int u = threadIdx.x; u < (LDS_BYTES - SCH_OFF) / 4; u += 512) ((LAS unsigned*)(lds + SCH_OFF))[u] = 0u;
    __syncthreads();
    volatile LAS unsigned* MISCW = (volatile LAS unsigned*)(lds + MISC_OFF);
    XcdBarrier bar; bar.bar = (unsigned*)((gu32*)(args.ws + WS_CTL) + CW_BAR); bar.x = 0; bar.st = nullptr;
    const int lo = args.ph_lo, hi = args.ph_hi;
    if (hi - lo > 1) bar = xcd_barrier_post(bar.bar, MISCW + 8);
#ifndef PH_MASK
#define PH_MASK 0xffffffffu
#endif
#define PHSEL(k) ((PH_MASK >> ((k) < 2 ? (k) : 2 + ((k) - 2) % 9)) & 1u)
#define RUN(k) (PHSEL(k) && lo <= (k) && (k) < hi)
#define SEAM(k) do { if (RUN((k) + 1)) xcd_barrier(bar); } while (0)
    LAS int* tstart = (LAS int*)(lds + SCH_OFF); LAS int* ecnt = tstart + 40;
    Ctx F;

    if (RUN(0)) { ctx_load(F, lds); p0_prologue(F); SEAM(0); }
    if (RUN(1)) { ctx_load(F, lds); phase_lnmod0(F); SEAM(1); }
#pragma unroll 1
    for (int l = 0; l < DEPTH; ++l) {
        const int pb = 2 + 9 * l;
        if (RUN(pb + 0)) {
            ctx_load(F, lds); unsigned char* ws = F.ws;
            DenseSched S; S.init(NTOK, NCOL, DM, (const bf16_t*)(ws + WS_WIN) + (size_t)l * NCOL * DM, F.G, (int)blockIdx.x);
            EpiInProj E{(bf16_t*)(ws + WS_P), (float*)(ws + WS_MISC)};
            pg8::gemm_phase(F.lds, (const bf16_t*)(ws + WS_H), DM, S, E);
            SEAM(pb + 0);
        }
#ifdef DBG_ZERO_SB
        if (RUN(pb + 1)) { ctx_load(F, lds); { u32x4* z = (u32x4*)(F.ws + WS_OB); for (size_t i = (size_t)blockIdx.x * 512 + F.tid; i < (size_t)NTOK * 512 * 2 / 16; i += (size_t)F.G * 512) z[i] = (u32x4){0u, 0u, 0u, 0u}; } ctx_load(F, lds); phase_misc(F, l); SEAM(pb + 1); }
#else
        if (RUN(pb + 1)) { ctx_load(F, lds); phase_sb(F); ctx_load(F, lds); phase_misc(F, l); SEAM(pb + 1); }
#endif
#ifdef DBG_ZERO_DSA
        if (RUN(pb + 2)) { ctx_load(F, lds); { u32x4* z = (u32x4*)(F.ws + WS_OLAT); for (size_t i = (size_t)blockIdx.x * 512 + F.tid; i < (size_t)NTOK * 1024 * 2 / 16; i += (size_t)F.G * 512) z[i] = (u32x4){0u, 0u, 0u, 0u}; } SEAM(pb + 2); }
#else
        if (RUN(pb + 2)) { ctx_load(F, lds); phase_dsa(F); SEAM(pb + 2); }
#endif
        if (RUN(pb + 3)) {
            { ctx_load(F, lds); unsigned char* ws = F.ws;
              DenseSched S; S.init(NTOK, DM, DM, (const bf16_t*)(ws + WS_WFA) + (size_t)l * DM * DM, F.G, (int)blockIdx.x);
              EpiMergeA E{(const bf16_t*)(ws + WS_P), (bf16_t*)(ws + WS_T)};
              pg8::gemm_phase(F.lds, (const bf16_t*)(ws + WS_OLAT), DM, S, E); }
            __syncthreads();
            { ctx_load(F, lds); unsigned char* ws = F.ws;
              DenseSched S; S.init(NTOK, DM, 512, (const bf16_t*)(ws + WS_WB) + (size_t)l * DM * 512, F.G, (int)blockIdx.x);
              EpiMergeB E{(const bf16_t*)(ws + WS_P), (const bf16_t*)(ws + WS_T), (bf16_t*)(ws + WS_MERGED)};
              pg8::gemm_phase(F.lds, (const bf16_t*)(ws + WS_OB), 512, S, E); }
            SEAM(pb + 3);
        }
        if (RUN(pb + 4)) {
            ctx_load(F, lds); unsigned char* ws = F.ws;
            const float* xin = (l == 0) ? F.x : F.out;
            const float* mod = (const float*)(ws + WS_MOD) + (size_t)l * 8 * 6144;
            DenseSched S; S.init(NTOK, DM, DM, (const bf16_t*)(ws + WS_WO) + (size_t)l * DM * DM, F.G, (int)blockIdx.x);
            EpiWo E{xin, mod + 2 * DM, (float*)(ws + WS_ZX)};
            pg8::gemm_phase(F.lds, (const bf16_t*)(ws + WS_MERGED), DM, S, E);
            SEAM(pb + 4);
        }
        if (RUN(pb + 5)) { ctx_load(F, lds); phase_ln_router(F, l); SEAM(pb + 5); }
        if (RUN(pb + 6) || RUN(pb + 7)) {
            ctx_load(F, lds);
            if (F.tid == 0) { int acc = 0; for (int e = 0; e < NEXP; ++e) { const int c = (int)__hip_atomic_load(F.ctl + CW_CNT + l * NEXP + e, RLX_AGENT); ecnt[e] = c; tstart[e] = acc; acc += (c + 255) >> 8; } tstart[NEXP] = acc; }
            __syncthreads();
        }
        if (RUN(pb + 6)) {
            ctx_load(F, lds); unsigned char* ws = F.ws;
            MoeSched S{tstart, ecnt, 8, __builtin_amdgcn_readfirstlane(tstart[NEXP]), F.G, (int)blockIdx.x, (const char*)((const bf16_t*)(ws + WS_WGU) + (size_t)l * NEXP * 2048 * 1024), (const unsigned*)(ws + WS_LIST), true};
            EpiGateUp E{F.b_gu + (size_t)l * NEXP * 2048, (bf16_t*)(ws + WS_ACT)};
            pg8::gemm_phase(F.lds, (const bf16_t*)(ws + WS_H), DM, S, E);
            SEAM(pb + 6);
        }
        if (RUN(pb + 7)) {
            ctx_load(F, lds); unsigned char* ws = F.ws;
            MoeSched S{tstart, ecnt, 4, __builtin_amdgcn_readfirstlane(tstart[NEXP]), F.G, (int)blockIdx.x, (const char*)((const bf16_t*)(ws + WS_WDN) + (size_t)l * NEXP * 1024 * 1024), (const unsigned*)(ws + WS_LIST), false};
            EpiDown E{F.b_dn + (size_t)l * NEXP * DM, (const unsigned*)(ws + WS_LIST), (const float*)(ws + WS_GATE), (bf16_t*)(ws + WS_YS), tstart, ecnt};
            pg8::gemm_phase(F.lds, (const bf16_t*)(ws + WS_ACT), DEXP, S, E);
            SEAM(pb + 7);
        }
        if (RUN(pb + 8)) { ctx_load(F, lds); phase_final(F, l, F.out, l + 1 < DEPTH); SEAM(pb + 8); }
    }
#undef RUN
#undef SEAM
}

extern "C" void kernel_launch(void* const* d_in, const int* in_sizes, int n_in, void* d_out, int out_size, void* d_ws, size_t ws_size, hipStream_t stream) {
    static int grid = 0;
    if (grid == 0) {
        if (n_in != 22 || out_size != NTOK * DM || ws_size < WS_END) { fprintf(stderr, "kernel_launch: unexpected shapes (n_in %d, out %d, ws %zu < %zu)\n", n_in, out_size, ws_size, (size_t)WS_END); grid = -1; return; }
        int dev = 0, cus = 0, per_cu = 0;
        if (hipGetDevice(&dev) != hipSuccess || hipDeviceGetAttribute(&cus, hipDeviceAttributeMultiprocessorCount, dev) != hipSuccess) { grid = -1; return; }
        if (hipFuncSetAttribute((const void*)mega_fwd, hipFuncAttributeMaxDynamicSharedMemorySize, LDS_BYTES) != hipSuccess) { fprintf(stderr, "kernel_launch: hipFuncSetAttribute failed\n"); grid = -1; return; }
        if (hipOccupancyMaxActiveBlocksPerMultiprocessor(&per_cu, (const void*)mega_fwd, 512, LDS_BYTES) != hipSuccess || per_cu < 1) fprintf(stderr, "kernel_launch: occupancy query says %d\n", per_cu);
        (void)hipGetLastError();
        grid = cus;
        if (grid > 256) grid = 256;
    }
    if (grid < 0) return;
    (void)hipMemsetAsync((char*)d_ws + WS_CTL, 0, CTL_ZERO_BYTES, stream);
    Args a{};
    for (int i = 0; i < 22; ++i) a.in[i] = (const float*)d_in[i];
    a.out = (float*)d_out; a.ws = (unsigned char*)d_ws;
#if MK_SINGLE
    a.ph_lo = 0; a.ph_hi = NPHASE;
    hipLaunchKernelGGL(mega_fwd, dim3(grid), dim3(512), LDS_BYTES, stream, a);
#else
    for (int p = 0; p < NPHASE; ++p) { a.ph_lo = p; a.ph_hi = p + 1; hipLaunchKernelGGL(mega_fwd, dim3(grid), dim3(512), LDS_BYTES, stream, a); }
#endif
}
```

```cpp
#include <hip/hip_runtime.h>
#include <cstdio>
#include <cstdint>
#include <cmath>

#define LAS __attribute__((address_space(3)))
#define GAS __attribute__((address_space(1)))
typedef unsigned short bf16_t;
typedef short bf16x8 __attribute__((ext_vector_type(8)));
typedef short s16x4 __attribute__((ext_vector_type(4)));
typedef float f32x4 __attribute__((ext_vector_type(4)));
typedef float f32x2 __attribute__((ext_vector_type(2)));
typedef __bf16 bf16x2_t __attribute__((ext_vector_type(2)));
typedef float f32x16 __attribute__((ext_vector_type(16)));
typedef unsigned u32x4 __attribute__((ext_vector_type(4)));
typedef unsigned u32x2 __attribute__((ext_vector_type(2)));
typedef int i32x4 __attribute__((ext_vector_type(4)));
typedef int i32x8 __attribute__((ext_vector_type(8)));
typedef GAS unsigned gu32;
#define RLX_AGENT __ATOMIC_RELAXED, __HIP_MEMORY_SCOPE_AGENT
#define DI __device__ __forceinline__

DI unsigned cvt_pk_bf16(float lo, float hi) { const f32x2 v = {lo, hi}; const bf16x2_t b = __builtin_convertvector(v, bf16x2_t); return __builtin_bit_cast(unsigned, b); }
DI float bf_lo(unsigned u) { return __uint_as_float(u << 16); }
DI float bf_hi(unsigned u) { return __uint_as_float(u & 0xffff0000u); }
DI float fast_exp2(float x) { return __builtin_amdgcn_exp2f(x); }
DI float fast_log2(float x) { return __builtin_amdgcn_logf(x); }
DI float fast_rcp(float x) { return __builtin_amdgcn_rcpf(x); }
DI float sigmoidf_(float x) { return fast_rcp(1.0f + fast_exp2(-1.4426950408889634f * x)); }

namespace pg8 {
constexpr int BM = 256, BK = 64, HALF = 128, HTB = HALF * BK * 2, STAGE_BYTES = 8 * HTB;
__host__ __device__ __forceinline__ int lds_byte(int r, int c) { const int st = (r >> 4) * 2 + (c >> 5), rr = r & 15, cc = c & 31, ob = rr * 64 + cc * 2; return st * 1024 + (ob ^ (((ob >> 9) & 1) << 5)); }
__host__ __device__ __forceinline__ void stage_rc(int b, int& R, int& C) { const int st = b / 1024, sb = b % 1024, swz = sb ^ (((sb >> 9) & 1) << 5); R = (st >> 1) * 16 + swz / 64; C = (st & 1) * 32 + (swz % 64) / 2; }
__host__ __device__ __forceinline__ int perm32(int rho) { const int n = rho >> 4, i = rho & 15; return 8 * (i >> 2) + 4 * n + (i & 3); }
struct Unit { int pm, pn, aux; };
template <int ES, class Epi, class Sched>
__device__ __forceinline__ void gemm_phase(LAS unsigned char* lds, const void* Abase_, const int K, const Sched& S, const Epi& E, int tid_in) {
    int tid_ = tid_in; asm volatile("" : "+v"(tid_));
    const int tid = tid_, wid = __builtin_amdgcn_readfirstlane(tid >> 6), lane = tid & 63, wr = wid >> 2, wc = wid & 3, fr = lane & 15, fq = lane >> 4;
    const int rowb = K * ES, nt = rowb / 128;
    const char* Abase = (const char*)Abase_;
    int Rr[2], Cc[2]; unsigned voffB[2];
#pragma unroll
    for (int i = 0; i < 2; ++i) { int R, C; stage_rc(tid * 16 + i * 8192, R, C); Rr[i] = R; Cc[i] = C; const int Rb = (R & ~31) + perm32(R & 31); voffB[i] = (unsigned)(Rb * rowb + C * 2); }
    const size_t kstep = (size_t)(BK * 2);
    const size_t hstep = (size_t)HALF * rowb;
    const size_t dPiece = (size_t)64 * rowb, dHalf = (size_t)HALF * rowb;
    const unsigned ldsw = (unsigned)wid * 1024u;
    const int aoff = lds_byte(wr * 64 + fr, (ES == 2) ? fq * 8 : fq * 16), boff = lds_byte(wc * 32 + fr, (ES == 2) ? fq * 8 : fq * 16);
    const int aoff1 = (ES == 2) ? aoff + 1024 : aoff + 16, boff1 = (ES == 2) ? boff + 1024 : boff + 16;
#define PG8_SA(b, h) (((b) * 2 + (h)) * HTB)
#define PG8_SB(b, h) ((4 + (b) * 2 + (h)) * HTB)
#define PG8_STAGE_B(bufoff, gbase) do { const char* _gb = (const char*)(gbase); asm volatile("" : "+s"(_gb)); _Pragma("unroll") for (int _i = 0; _i < 2; ++_i) \
        __builtin_amdgcn_global_load_lds((const unsigned*)(_gb + voffB[_i]), (LAS unsigned*)(lds + (bufoff) + ldsw + _i * 8192), 16, 0, 0); } while (0)
#define PG8_STAGE_A(bufoff, kb, o0, o1) do { const char* _ga = Abase + (size_t)(kb) + ((Sched::GATHER || ((bufoff) & HTB) == 0) ? (size_t)0 : dHalf); asm volatile("" : "+s"(_ga)); \
        const char* _gb2 = _ga + (Sched::GATHER ? (size_t)0 : dPiece); asm volatile("" : "+s"(_gb2)); \
        __builtin_amdgcn_global_load_lds((const unsigned*)(_ga + (o0)), (LAS unsigned*)(lds + (bufoff) + ldsw), 16, 0, 0); \
        __builtin_amdgcn_global_load_lds((const unsigned*)(_gb2 + (o1)), (LAS unsigned*)(lds + (bufoff) + ldsw + 8192), 16, 0, 0); } while (0)
#define PG8_CAT8(p0, p1) __builtin_shufflevector(*(const LAS i32x4*)(p0), *(const LAS i32x4*)(p1), 0, 1, 2, 3, 4, 5, 6, 7)
#define PG8_LDA(dst, b, h) do { if (ES == 2) { _Pragma("unroll") for (int m = 0; m < 4; ++m) _Pragma("unroll") for (int k = 0; k < 2; ++k) dst[m][k] = *(const LAS bf16x8*)(lds + PG8_SA(b, h) + (k ? aoff1 : aoff) + m * 2048); } \
        else { _Pragma("unroll") for (int m = 0; m < 4; ++m) dst##8[m] = PG8_CAT8(lds + PG8_SA(b, h) + aoff + m * 2048, lds + PG8_SA(b, h) + aoff1 + m * 2048); } } while (0)
#define PG8_LDB(dst, b, h) do { if (ES == 2) { _Pragma("unroll") for (int n = 0; n < 2; ++n) _Pragma("unroll") for (int k = 0; k < 2; ++k) dst[n][k] = *(const LAS bf16x8*)(lds + PG8_SB(b, h) + (k ? boff1 : boff) + n * 2048); } \
        else { _Pragma("unroll") for (int n = 0; n < 2; ++n) dst##8[n] = PG8_CAT8(lds + PG8_SB(b, h) + boff + n * 2048, lds + PG8_SB(b, h) + boff1 + n * 2048); } } while (0)
#define PG8_MMA(ai, bj, At, Bt) do { __builtin_amdgcn_s_setprio(1); _Pragma("unroll") for (int m = 0; m < 4; ++m) _Pragma("unroll") for (int n = 0; n < 2; ++n) { \
        if (ES == 2) { _Pragma("unroll") for (int k = 0; k < 2; ++k) acc[ai][bj][m][n] = __builtin_amdgcn_mfma_f32_16x16x32_bf16(Bt[n][k], At[m][k], acc[ai][bj][m][n], 0, 0, 0); } \
        else asm volatile("v_mfma_f32_16x16x128_f8f6f4 %0, %1, %2, %0" : "+v"(acc[ai][bj][m][n]) : "v"(Bt##8[n]), "v"(At##8[m])); }   \
        __builtin_amdgcn_s_setprio(0); } while (0)
#define PG8_WAIT_V(n) asm volatile("s_waitcnt vmcnt(" #n ")" ::: "memory")
#define PG8_WAIT_L(n) asm volatile("s_waitcnt lgkmcnt(" #n ")" ::: "memory")
#define PG8_BAR __builtin_amdgcn_s_barrier()
#define PG8_SCHED __builtin_amdgcn_sched_barrier(0)
    Unit cur, nxt; int ui = 0;
    if (!S.next(0, cur)) return;
    f32x4 acc[2][2][4][2];
    E.init(acc, cur, wc, fq);
    bf16x8 At[4][2], B0[2][2], B1[2][2];
    i32x8 At8[4], B08[2], B18[2];
    unsigned c00 = S.a_row_fin(S.a_row_raw(cur, Rr[0])) + Cc[0] * 2u, c01, c10, c11;
    if (Sched::GATHER) { c01 = S.a_row_fin(S.a_row_raw(cur, Rr[1])) + Cc[1] * 2u; c10 = S.a_row_fin(S.a_row_raw(cur, HALF + Rr[0])) + Cc[0] * 2u; c11 = S.a_row_fin(S.a_row_raw(cur, HALF + Rr[1])) + Cc[1] * 2u; }
    else { c01 = c00; c10 = c00; c11 = c00; }
    unsigned n00 = c00, n01 = c01, n10 = c10, n11 = c11;
    const char* cB = S.b_tile(cur); const char* nB = cB;
    Unit nn; bool have_nxt = S.next(1, nxt);
    unsigned r0 = 0u, r1 = 0u, r2 = 0u, r3 = 0u;
    if (Sched::GATHER && have_nxt) { r0 = S.a_row_raw(nxt, Rr[0]); r1 = S.a_row_raw(nxt, Rr[1]); r2 = S.a_row_raw(nxt, HALF + Rr[0]); r3 = S.a_row_raw(nxt, HALF + Rr[1]); }
    PG8_STAGE_B(PG8_SB(0, 0), cB); PG8_STAGE_B(PG8_SB(0, 1), cB + hstep); PG8_STAGE_A(PG8_SA(0, 0), 0, c00, c01); PG8_STAGE_A(PG8_SA(0, 1), 0, c10, c11);
    if (wr == 1) PG8_BAR;
    PG8_WAIT_V(2); PG8_BAR;
    PG8_STAGE_B(PG8_SB(1, 0), cB + kstep); PG8_STAGE_A(PG8_SA(1, 0), kstep, c00, c01); PG8_STAGE_B(PG8_SB(1, 1), cB + hstep + kstep);
    PG8_WAIT_V(6); PG8_BAR;
    for (;;) {
        const bool has_next = have_nxt;
        if (has_next) {
            if (Sched::GATHER) { n00 = S.a_row_fin(r0) + Cc[0] * 2u; n01 = S.a_row_fin(r1) + Cc[1] * 2u; n10 = S.a_row_fin(r2) + Cc[0] * 2u; n11 = S.a_row_fin(r3) + Cc[1] * 2u; }
            else { n00 = S.a_row_fin(S.a_row_raw(nxt, Rr[0])) + Cc[0] * 2u; n01 = n00; n10 = n00; n11 = n00; }
            nB = S.b_tile(nxt); }
        else { n00 = c00; n01 = c01; n10 = c10; n11 = c11; nB = cB; }
        const bool have_nn = has_next && S.next(ui + 2, nn);
        if (Sched::GATHER && have_nn) { r0 = S.a_row_raw(nn, Rr[0]); r1 = S.a_row_raw(nn, Rr[1]); r2 = S.a_row_raw(nn, HALF + Rr[0]); r3 = S.a_row_raw(nn, HALF + Rr[1]); }
        for (int t = 0; t < nt; t += 2) {
            const bool last = (t == nt - 2);
            const size_t k1 = (size_t)(t + 1) * kstep;
            const size_t k2 = last ? 0 : (size_t)(t + 2) * kstep, k3 = k2 + kstep;
            const char* b2 = last ? nB : cB + (size_t)(t + 2) * kstep; const char* b3 = b2 + kstep;
            const unsigned o00 = last ? n00 : c00, o01 = last ? n01 : c01, o10 = last ? n10 : c10, o11 = last ? n11 : c11;
            PG8_LDB(B0, 0, 0); PG8_LDB(B1, 0, 1); PG8_SCHED; PG8_LDA(At, 0, 0); PG8_STAGE_A(PG8_SA(1, 1), k1, c10, c11);
            PG8_WAIT_V(8); PG8_WAIT_L(0); PG8_BAR; PG8_MMA(0, 0, At, B0); PG8_MMA(0, 1, At, B1); PG8_BAR; PG8_SCHED;
            PG8_LDA(At, 0, 1); PG8_STAGE_B(PG8_SB(0, 0), b2); PG8_STAGE_B(PG8_SB(0, 1), b2 + hstep); PG8_STAGE_A(PG8_SA(0, 0), k2, o00, o01);
            PG8_WAIT_V(8); PG8_WAIT_L(0); PG8_BAR; PG8_MMA(1, 0, At, B0); PG8_MMA(1, 1, At, B1); PG8_BAR; PG8_SCHED;
            PG8_LDB(B0, 1, 0); PG8_LDB(B1, 1, 1); PG8_SCHED; PG8_LDA(At, 1, 0); PG8_STAGE_A(PG8_SA(0, 1), k2, o10, o11);
            PG8_WAIT_V(8); PG8_WAIT_L(0); PG8_BAR; PG8_MMA(0, 0, At, B0); PG8_MMA(0, 1, At, B1); PG8_BAR; PG8_SCHED;
            PG8_LDA(At, 1, 1); PG8_STAGE_B(PG8_SB(1, 0), b3); PG8_STAGE_B(PG8_SB(1, 1), b3 + hstep); PG8_STAGE_A(PG8_SA(1, 0), k3, o00, o01);
            PG8_WAIT_V(8); PG8_WAIT_L(0); PG8_BAR; PG8_MMA(1, 0, At, B0); PG8_MMA(1, 1, At, B1); PG8_BAR; PG8_SCHED;
        }
        if (wr == 0) PG8_BAR;
        if (ES == 1) asm volatile("s_nop 15\n\ts_nop 7" ::: "memory");
        E(acc, cur, wr, wc, fr, fq);
        if (!has_next) break;
        E.init(acc, nxt, wc, fq);
        if (ES == 1) asm volatile("s_nop 7" ::: "memory");
        cur = nxt; c00 = n00; c01 = n01; c10 = n10; c11 = n11; cB = nB; ++ui; nxt = nn; have_nxt = have_nn;
        if (wr == 1) PG8_BAR;
    }
    PG8_WAIT_V(0);
    PG8_BAR;
#undef PG8_SA
#undef PG8_SB
#undef PG8_STAGE_A
#undef PG8_STAGE_B
#undef PG8_LDA
#undef PG8_LDB
#undef PG8_MMA
#undef PG8_WAIT_V
#undef PG8_WAIT_L
#undef PG8_BAR
#undef PG8_SCHED
}
}
#define XB_TMO      128
#define XB_XCNT(j)  (256  + 64 * (j))
#define XB_XSUB(j)  (1280 + 64 * (j))
#define XB_XGEN(j)  (2304 + 64 * (j))
#define XB_TOP      3328
#define XB_TOPGEN   3392
#define XCD_BAR_WORDS 3456
#define XB_SPIN_CAP (1u << 18)

__device__ __forceinline__ unsigned xb_ld(unsigned* p)              { return __hip_atomic_load(p, __ATOMIC_RELAXED, __HIP_MEMORY_SCOPE_AGENT); }
__device__ __forceinline__ unsigned xb_add(unsigned* p, unsigned v) { return __hip_atomic_fetch_add(p, v, __ATOMIC_RELAXED, __HIP_MEMORY_SCOPE_AGENT); }
__device__ __forceinline__ unsigned xb_xcc_id() { return (unsigned)__builtin_amdgcn_s_getreg((3 << 11) | 20) & 0xFu; }
#define XB_SPIN(cond, bar) do { unsigned _sp = 0; while (cond) { __builtin_amdgcn_s_sleep(1); \
    if ((++_sp & 255u) == 0u) { if (xb_ld(&(bar)[XB_TMO])) break; if (_sp > XB_SPIN_CAP) { atomicAdd(&(bar)[XB_TMO], 1u); break; } } } } while (0)

struct XcdBarrier {
    unsigned* bar; unsigned x; int wv;
    volatile LAS unsigned* st;
};

__device__ __forceinline__ XcdBarrier xcd_barrier_post(unsigned* bar, volatile LAS unsigned* st) {
    XcdBarrier b; b.bar = bar; b.x = xb_xcc_id(); b.st = st; b.wv = 0;
    if (threadIdx.x == 0) (void)xb_add(&bar[XB_XCNT(b.x)], 1u);
    return b;
}
__device__ __forceinline__ void xcd_barrier_complete(unsigned* bar, unsigned x, unsigned& nloc, unsigned& nx) {
    const unsigned G = gridDim.x * gridDim.y * gridDim.z;
    unsigned sum, cnt, mine, sp = 0u;
    for (;;) {
        sum = 0u; cnt = 0u; mine = 0u;
#pragma unroll
        for (unsigned j = 0; j < 16; ++j) { const unsigned c = xb_ld(&bar[XB_XCNT(j)]); sum += c; cnt += (c > 0u) ? 1u : 0u; mine = (j == x) ? c : mine; }
        if (sum == G) break;
        __builtin_amdgcn_s_sleep(1);
        if ((++sp & 255u) == 0u) { if (xb_ld(&bar[XB_TMO])) break; if (sp > XB_SPIN_CAP) { atomicAdd(&bar[XB_TMO], 1u); break; } }
    }
    nloc = mine > 0u ? mine : 1u; nx = cnt > 0u ? cnt : 1u;
}

__device__ __forceinline__ void xcd_barrier(const XcdBarrier& b) {
    asm volatile("s_waitcnt vmcnt(0)" ::: "memory");
    __syncthreads();
    if (b.wv == 0 && __builtin_amdgcn_mbcnt_hi(~0u, __builtin_amdgcn_mbcnt_lo(~0u, 0u)) == 0u) {
        unsigned* bar = b.bar;
        __builtin_amdgcn_s_waitcnt(0);
        unsigned nloc = b.st[0], nx = b.st[1];
        if (nloc == 0u) { xcd_barrier_complete(bar, b.x, nloc, nx); b.st[0] = nloc; b.st[1] = nx; }
        const unsigned old = xb_add(&bar[XB_XSUB(b.x)], 1u);
        const unsigned gen = old / nloc;
        if (old + 1u == (gen + 1u) * nloc) {
            __builtin_amdgcn_fence(__ATOMIC_RELEASE, "agent");
            asm volatile("s_waitcnt vmcnt(0)" ::: "memory");
            const unsigned og = xb_add(&bar[XB_TOP], 1u);
            const unsigned tg = og / nx;
            if (og + 1u == (tg + 1u) * nx) xb_add(&bar[XB_TOPGEN], 1u);
            else XB_SPIN(xb_ld(&bar[XB_TOPGEN]) == tg, bar);
            __builtin_amdgcn_fence(__ATOMIC_ACQUIRE, "agent");
            xb_add(&bar[XB_XGEN(b.x)], 1u);
            asm volatile("s_waitcnt vmcnt(0)" ::: "memory");
        } else {
            XB_SPIN(xb_ld(&bar[XB_XGEN(b.x)]) == gen, bar);
            __builtin_amdgcn_fence(__ATOMIC_ACQUIRE, "agent");
            asm volatile("s_waitcnt vmcnt(0)" ::: "memory");
        }
    }
    __syncthreads();
}

constexpr int NB = 8, SEQ = 8192, DM = 1024, NTOK = NB * SEQ, DEPTH = 2;
constexpr int NHA = 8, KVR = 128, NIH = 4, IDXD = 64, TOPK = 256, NHB = 8, HD = 64;
constexpr int NEXP = 32, MTOPK = 4, DEXP = 1024;
constexpr int NCOLS_SRC = 4548, NCOL = 5120;
constexpr int SRC_CKV = 512, SRC_QIDX = 640, SRC_KIDX = 896, SRC_WIDX = 960, SRC_QB = 964, SRC_KB = 1476, SRC_VB = 1988, SRC_GA = 2500, SRC_GB = 3524;
constexpr int PC_QLAT = 0, PC_MISC = 1024, PC_QIDX = 1280, PC_QB = 1536, PC_KB = 2048, PC_VB = 2560, PC_GA = 3072, PC_GB = 4096;
constexpr float LN_EPS = 1e-5f, RMS_EPS = 1e-6f;
constexpr float DN_ALPHA = 1.4142135623730951f;
constexpr float LOG2E = 1.4426950408889634f;
constexpr float SB_QSCALE = 0.125f * LOG2E;
constexpr float SB_STOP = 48.0f;
constexpr int ACT_ROWS = NTOK * MTOPK + NEXP * 256;
constexpr float WGU_SCALE = 32.0f, WDN_SCALE = 64.0f, WIN_SCALE = 32.0f, WQL_SCALE = 256.0f, WFA_SCALE = 128.0f, WB_SCALE = 32.0f, WO_SCALE = 64.0f;
constexpr float OLAT_SCALE = 8.0f, OB_SCALE = 8.0f, MG_SCALE = 16.0f;

constexpr size_t MiB = 1u << 20;
constexpr size_t WS_CTL = 0, CTL_ZERO_BYTES = 1 * MiB;
constexpr size_t WS_MOD = 1 * MiB, WS_WIDX = 2 * MiB, WS_GATE = 3 * MiB, WS_LIST = 4 * MiB;
constexpr size_t WS_WIN = 12 * MiB, WS_WFA = 32 * MiB, WS_WB = 36 * MiB, WS_WO = 38 * MiB, WS_WGU = 42 * MiB, WS_WDN = 298 * MiB;
constexpr size_t WS_CKV = 426 * MiB, WS_KIDX = 442 * MiB, WS_H = 450 * MiB, WS_ZX = 578 * MiB, WS_XB = 706 * MiB;
constexpr size_t WS_P = 834 * MiB, WS_ACT = 834 * MiB;
constexpr size_t WS_OLAT = 1474 * MiB, WS_OB = 1602 * MiB, WS_T = 1666 * MiB, WS_MISC = 1666 * MiB, WS_MERGED = 1794 * MiB, WS_YS = 1474 * MiB;
constexpr size_t WS_GATEL = 1986 * MiB;
constexpr size_t WS_END = 1994 * MiB;
static_assert(WS_ACT + (size_t)ACT_ROWS * DEXP * 2 <= WS_OLAT, "ACT fits in R1");
static_assert(WS_P + (size_t)NTOK * NCOL * 2 <= WS_OLAT, "P fits in R1");
constexpr int CW_BAR = 4096;
constexpr int CW_CNT = 8192;
constexpr int CW_DSAQ = 9216;

constexpr int LDS_BYTES = 163840;
constexpr int MISC_OFF = LDS_BYTES - 512;
constexpr int SCH_OFF = LDS_BYTES - 1024;

#define LDS_WAIT() asm volatile("s_waitcnt lgkmcnt(0)" ::: "memory")
#define VM_WAIT() asm volatile("s_waitcnt vmcnt(0)" ::: "memory")

#define DPPF(v, ctrl) __uint_as_float((unsigned)__builtin_amdgcn_update_dpp(0, (int)__float_as_uint(v), (ctrl), 0xf, 0xf, false))
DI float wave_sum(float v) {
    v += DPPF(v, 0xB1); v += DPPF(v, 0x4E); v += DPPF(v, 0x141); v += DPPF(v, 0x140);
    const float r0 = __uint_as_float((unsigned)__builtin_amdgcn_readlane((int)__float_as_uint(v), 0)), r1 = __uint_as_float((unsigned)__builtin_amdgcn_readlane((int)__float_as_uint(v), 16));
    const float r2 = __uint_as_float((unsigned)__builtin_amdgcn_readlane((int)__float_as_uint(v), 32)), r3 = __uint_as_float((unsigned)__builtin_amdgcn_readlane((int)__float_as_uint(v), 48));
    return (r0 + r1) + (r2 + r3);
}

struct Ctx {
    LAS unsigned char* lds;
    int tid, lane, wave, vcu, G;
    const float *x, *c, *rel_bias, *w_ada, *b_ada, *w_in, *g_kv, *w_uk, *w_uv, *w_a_out, *w_b_out, *w_o, *ln1_g, *ln1_b, *w_router, *b_router, *w_gu, *b_gu, *w_dn, *b_dn, *ln2_g, *ln2_b;
    float* out; unsigned char* ws; gu32* ctl;
};

template <class Map>
DI void transpose_item(const float* W, int K, int Nsrc, bf16_t* WT, LAS float* scr, int item, int nblk_dst, int lane, const Map& map) {
    const int kb = item / nblk_dst, nb = item % nblk_dst, k0 = 128 * kb, n0 = 32 * nb;
    const int sc = map(n0 + (lane & 31));
    float tv[64];
    const float* src = W + (size_t)(k0 + (lane >> 5)) * Nsrc + (sc >= 0 ? sc : 0);
#pragma unroll
    for (int i = 0; i < 64; ++i) tv[i] = __builtin_nontemporal_load(src + (size_t)(2 * i) * Nsrc);
#pragma unroll
    for (int i = 0; i < 64; ++i) scr[(2 * i + (lane >> 5)) * 33 + (lane & 31)] = (sc >= 0) ? tv[i] : 0.f;
    LDS_WAIT(); asm volatile("" ::: "memory");
    const int c = lane & 15;
#pragma unroll
    for (int j = 0; j < 8; ++j) { const int n = (lane >> 4) + 4 * j; const LAS float* s = scr + (8 * c) * 33 + n;
        u32x4 o; o.x = cvt_pk_bf16(s[0 * 33], s[1 * 33]); o.y = cvt_pk_bf16(s[2 * 33], s[3 * 33]); o.z = cvt_pk_bf16(s[4 * 33], s[5 * 33]); o.w = cvt_pk_bf16(s[6 * 33], s[7 * 33]);
        *(GAS u32x4*)(WT + (size_t)(n0 + n) * K + k0 + 8 * c) = o; }
    LDS_WAIT(); asm volatile("" ::: "memory");
}
DI unsigned pack_fp8x4(float a, float b, float c, float d) {
    unsigned p = (unsigned)__builtin_amdgcn_cvt_pk_fp8_f32(a, b, 0, false);
    return (unsigned)__builtin_amdgcn_cvt_pk_fp8_f32(c, d, (int)p, true);
}
template <class Map>
DI void transpose_item_fp8(const float* W, int K, int Nsrc, unsigned char* WT, LAS float* scr, int item, int nblk_dst, int lane, const Map& map, float scale) {
    const int kb = item / nblk_dst, nb = item % nblk_dst, k0 = 128 * kb, n0 = 32 * nb;
    const int sc = map(n0 + (lane & 31));
    float tv[64];
    const float* src = W + (size_t)(k0 + (lane >> 5)) * Nsrc + (sc >= 0 ? sc : 0);
#pragma unroll
    for (int i = 0; i < 64; ++i) tv[i] = __builtin_nontemporal_load(src + (size_t)(2 * i) * Nsrc);
#pragma unroll
    for (int i = 0; i < 64; ++i) scr[(2 * i + (lane >> 5)) * 33 + (lane & 31)] = (sc >= 0) ? tv[i] * scale : 0.f;
    LDS_WAIT(); asm volatile("" ::: "memory");
    const int c = lane & 15;
#pragma unroll
    for (int j = 0; j < 8; ++j) { const int n = (lane >> 4) + 4 * j; const LAS float* s = scr + (8 * c) * 33 + n;
        u32x2 o; o.x = pack_fp8x4(s[0 * 33], s[1 * 33], s[2 * 33], s[3 * 33]); o.y = pack_fp8x4(s[4 * 33], s[5 * 33], s[6 * 33], s[7 * 33]);
        *(GAS u32x2*)(WT + (size_t)(n0 + n) * K + k0 + 8 * c) = o; }
    LDS_WAIT(); asm volatile("" ::: "memory");
}
struct MapIn {
    DI int operator()(int n) const {
        if (n < 1152) return SRC_CKV + (n - 1024);
        if (n < 1216) return SRC_KIDX + (n - 1152);
        if (n < 1220) return SRC_WIDX + (n - 1216);
        if (n < 1280) return -1;
        if (n < 1536) return SRC_QIDX + (n - 1280);
        if (n < 2048) return SRC_QB + (n - 1536);
        if (n < 2560) return SRC_KB + (n - 2048);
        if (n < 3072) return SRC_VB + (n - 2560);
        if (n < 4096) return SRC_GA + (n - 3072);
        return SRC_GB + (n - 4096);
    }
};
struct MapGU { DI int operator()(int n) const { const int t = n >> 8, w = n & 255; return (w < 128) ? (t * 128 + w) : (1024 + t * 128 + (w - 128)); } };
struct MapId { DI int operator()(int n) const { return n; } };

DI void p0_prologue(Ctx& F) {
    LAS float* scr = (LAS float*)(F.lds + F.wave * 16896);
    const int gw = F.vcu * 8 + F.wave, NGW = F.G * 8;
    constexpr int I_IN = 8 * 128, I_GU = 8 * 64, I_DN = 8 * 32, I_B = 4 * 32, I_O = 8 * 32;
    constexpr int T_IN = DEPTH * I_IN, T_GU = DEPTH * NEXP * I_GU, T_DN = DEPTH * NEXP * I_DN, T_B = DEPTH * I_B, T_O = DEPTH * I_O;
    constexpr int NITEMS = T_IN + T_GU + T_DN + T_B + T_O;
    for (int it = gw; it < NITEMS; it += NGW) {
        int r = it;
        if (r < T_GU) { const int m = r / I_GU; transpose_item_fp8(F.w_gu + (size_t)m * 1024 * 2048, 1024, 2048, (unsigned char*)(F.ws + WS_WGU) + (size_t)m * 2048 * 1024, scr, r % I_GU, 64, F.lane, MapGU(), WGU_SCALE); continue; } r -= T_GU;
        if (r < T_DN) { const int m = r / I_DN; transpose_item_fp8(F.w_dn + (size_t)m * 1024 * 1024, 1024, 1024, (unsigned char*)(F.ws + WS_WDN) + (size_t)m * 1024 * 1024, scr, r % I_DN, 32, F.lane, MapId(), WDN_SCALE); continue; } r -= T_DN;
        if (r < T_IN) { const int l = r / I_IN; const int q = r % I_IN; const int kb = q / 128, nb = q % 128;
            struct M2 { DI int operator()(int n) const { return MapIn()(n + 1024); } };
            transpose_item_fp8(F.w_in + (size_t)l * 1024 * NCOLS_SRC, 1024, NCOLS_SRC, (unsigned char*)(F.ws + WS_WIN) + (size_t)l * NCOL * 1024 + (size_t)1024 * 1024, scr, kb * 128 + nb, 128, F.lane, M2(), WIN_SCALE); continue; } r -= T_IN;
        if (r < T_B) { const int l = r / I_B; transpose_item_fp8(F.w_b_out + (size_t)l * 512 * 1024, 512, 1024, (unsigned char*)(F.ws + WS_WB) + (size_t)l * 1024 * 512, scr, r % I_B, 32, F.lane, MapId(), WB_SCALE); continue; } r -= T_B;
        { const int l = r / I_O; transpose_item_fp8(F.w_o + (size_t)l * 1024 * 1024, 1024, 1024, (unsigned char*)(F.ws + WS_WO) + (size_t)l * 1024 * 1024, scr, r % I_O, 32, F.lane, MapId(), WO_SCALE); }
    }
    __syncthreads();
    LAS float* As = (LAS float*)F.lds;
    LAS float* Bs = (LAS float*)(F.lds + 128 * 65 * 4);
    constexpr int J_QL = DEPTH * 8 * 16, J_FA = DEPTH * 8 * 16, J_MOD = DEPTH * 96;
    for (int j = F.vcu; j < J_QL + J_FA + J_MOD; j += F.G) {
        if (j < J_QL) {
            const int l = j / 128, h = (j % 128) / 16, k0 = ((j % 128) % 16) * 64;
            for (int u = F.tid; u < 128 * 64; u += 512) { const int r = u >> 6, d = u & 63; As[r * 65 + d] = F.w_uk[(((size_t)l * 128 + r) * 8 + h) * 64 + d]; }
            for (int u = F.tid; u < 64 * 64; u += 512) { const int k = u >> 6, d = u & 63; Bs[k * 65 + d] = F.w_in[((size_t)l * 1024 + k0 + k) * NCOLS_SRC + h * 64 + d]; }
            __syncthreads();
            unsigned char* dst = (unsigned char*)(F.ws + WS_WIN) + (size_t)l * NCOL * 1024;
            { const int rt = F.wave >> 1, kt = F.wave & 1, r32 = F.lane & 31, hi = F.lane >> 5;
              f32x16 acc;
#pragma unroll
              for (int i = 0; i < 16; ++i) acc[i] = 0.f;
#pragma unroll 8
              for (int st = 0; st < 32; ++st) acc = __builtin_amdgcn_mfma_f32_32x32x2f32(As[(rt * 32 + r32) * 65 + 2 * st + hi], Bs[(kt * 32 + r32) * 65 + 2 * st + hi], acc, 0, 0, 0);
#pragma unroll
              for (int i = 0; i < 16; ++i) { const int r = rt * 32 + (i & 3) + 8 * (i >> 2) + 4 * hi, k = kt * 32 + r32;
                  dst[(size_t)(h * 128 + r) * 1024 + k0 + k] = (unsigned char)(pack_fp8x4(0.125f * WQL_SCALE * acc[i], 0.f, 0.f, 0.f) & 0xffu); } }
            __syncthreads();
        } else if (j < J_QL + J_FA) {
            const int jj = j - J_QL; const int l = jj / 128, h = (jj % 128) / 16, n0 = ((jj % 128) % 16) * 64;
            for (int u = F.tid; u < 128 * 64; u += 512) { const int r = u >> 6, d = u & 63; As[r * 65 + d] = F.w_uv[(((size_t)l * 128 + r) * 8 + h) * 64 + d]; }
            for (int u = F.tid; u < 64 * 64; u += 512) { const int d = u >> 6, n = u & 63; Bs[d * 65 + n] = F.w_a_out[((size_t)l * 512 + h * 64 + d) * 1024 + n0 + n]; }
            __syncthreads();
            unsigned char* dst = (unsigned char*)(F.ws + WS_WFA) + (size_t)l * 1024 * 1024;
            { const int rt = F.wave >> 1, nt = F.wave & 1, r32 = F.lane & 31, hi = F.lane >> 5;
              f32x16 acc;
#pragma unroll
              for (int i = 0; i < 16; ++i) acc[i] = 0.f;
#pragma unroll 8
              for (int st = 0; st < 32; ++st) acc = __builtin_amdgcn_mfma_f32_32x32x2f32(As[(rt * 32 + r32) * 65 + 2 * st + hi], Bs[(2 * st + hi) * 65 + nt * 32 + r32], acc, 0, 0, 0);
#pragma unroll
              for (int i = 0; i < 16; ++i) { const int r = rt * 32 + (i & 3) + 8 * (i >> 2) + 4 * hi, n = nt * 32 + r32;
                  dst[(size_t)(n0 + n) * 1024 + h * 128 + r] = (unsigned char)(pack_fp8x4(WFA_SCALE * acc[i], 0.f, 0.f, 0.f) & 0xffu); } }
            __syncthreads();
        } else {
            const int jj = j - J_QL - J_FA; const int l = jj / 96, cg = jj % 96;
            LAS float* sc = (LAS float*)F.lds;
            LAS float* part = (LAS float*)(F.lds + 32768);
            for (int u = F.tid; u < 8 * 1024; u += 512) { const float v = F.c[u]; sc[u] = v * sigmoidf_(v); }
            __syncthreads();
            const int col = F.tid & 63, ks = F.tid >> 6;
            float a[8];
#pragma unroll
            for (int b = 0; b < 8; ++b) a[b] = 0.f;
            const float* wp = F.w_ada + ((size_t)l * 1024 + ks * 128) * 6144 + cg * 64 + col;
            for (int k = 0; k < 128; ++k) { const float w = wp[(size_t)k * 6144];
#pragma unroll
                for (int b = 0; b < 8; ++b) a[b] += sc[b * 1024 + ks * 128 + k] * w; }
#pragma unroll
            for (int b = 0; b < 8; ++b) part[(ks * 8 + b) * 64 + col] = a[b];
            __syncthreads();
            { const int b = F.tid >> 6; float s = F.b_ada[(size_t)l * 6144 + cg * 64 + col];
#pragma unroll
              for (int k2 = 0; k2 < 8; ++k2) s += part[(k2 * 8 + b) * 64 + col];
              ((float*)(F.ws + WS_MOD))[((size_t)l * 8 + b) * 6144 + cg * 64 + col] = s; }
            __syncthreads();
        }
    }
}

DI void load_row(const float* p, int lane, f32x4 (&v)[4]) {
#pragma unroll
    for (int j = 0; j < 4; ++j) v[j] = __builtin_nontemporal_load((const GAS f32x4*)p + lane + 64 * j);
}
DI void load_row_bf16(const bf16_t* p, int lane, f32x4 (&v)[4]) {
#pragma unroll
    for (int j = 0; j < 4; ++j) { const u32x2 w = *((const GAS u32x2*)p + lane + 64 * j); v[j] = (f32x4){bf_lo(w.x), bf_hi(w.x), bf_lo(w.y), bf_hi(w.y)}; }
}
DI void ln_stats(const f32x4 (&v)[4], float& mean, float& rstd) {
    float s = 0.f;
#pragma unroll
    for (int j = 0; j < 4; ++j) s += (v[j].x + v[j].y) + (v[j].z + v[j].w);
    mean = wave_sum(s) * (1.f / DM); float s2 = 0.f;
#pragma unroll
    for (int j = 0; j < 4; ++j) { const f32x4 d = v[j] - mean; s2 += (d.x * d.x + d.y * d.y) + (d.z * d.z + d.w * d.w); }
    rstd = 1.f / sqrtf(wave_sum(s2) * (1.f / DM) + LN_EPS);
}
DI void modulate_store(const f32x4 (&v)[4], const float* shift, const float* scale, unsigned char* orow, int lane) {
    float mean, rstd; ln_stats(v, mean, rstd);
#pragma unroll
    for (int j = 0; j < 4; ++j) {
        const f32x4 sh = *((const GAS f32x4*)shift + lane + 64 * j), sc = *((const GAS f32x4*)scale + lane + 64 * j);
        const f32x4 o = (v[j] - mean) * rstd * (sc + 1.0f) + sh;
        *((GAS unsigned*)orow + lane + 64 * j) = pack_fp8x4(o.x, o.y, o.z, o.w);
    }
}

struct DenseSched {
    static constexpr bool GATHER = false;
    int nM, nN, nwg, G, c, K; const char* Bt;
    DI void init(int M, int N, int Kbytes, const void* Bt_, int G_, int c_) { nM = M / 256; nN = N / 256; nwg = nM * nN; G = G_; c = c_; K = Kbytes; Bt = (const char*)Bt_; }
    DI bool next(int i, pg8::Unit& u) const {
        const long L = (long)i * G + c; if (L >= nwg) return false;
        int wgid = (int)L; { const int q = nwg / 8, r = nwg % 8, xcd = wgid % 8, off = wgid / 8; wgid = (xcd < r ? xcd * (q + 1) : r * (q + 1) + (xcd - r) * q) + off; }
        const int nig = 8 * nN, gid = wgid / nig, fm = gid * 8, gsz = (nM - fm) < 8 ? (nM - fm) : 8;
        u.pm = fm + ((wgid % nig) % gsz); u.pn = (wgid % nig) / gsz; u.aux = 0; return true;
    }
    DI unsigned a_row_raw(const pg8::Unit& u, int row) const { return (unsigned)(u.pm * 256 + row) * (unsigned)K; }
    DI unsigned a_row_fin(unsigned raw) const { return raw; }
    DI const char* b_tile(const pg8::Unit& u) const { return Bt + (size_t)__builtin_amdgcn_readfirstlane(u.pn) * 256 * K; }
};
template <bool GATHER_>
struct MoeSched {
    static constexpr bool GATHER = GATHER_; static constexpr bool gather = GATHER_;
    const LAS int* tstart; const LAS int* cnt; int NCT, ntiles, G, c; const char* Bt; const unsigned* list;
    DI bool next(int i, pg8::Unit& u) const {
        int gt, ct;
        if ((G & 7) == 0) { const int nb = G >> 3, x = c & 7, j = c >> 3, uu = i * nb + j; gt = (uu / NCT) * 8 + x; ct = uu % NCT; if (gt >= ntiles) return false; }
        else { const long L = (long)i * G + c; if (L >= (long)ntiles * NCT) return false; gt = (int)(L / NCT); ct = (int)(L % NCT); }
        int e = -1;
#pragma unroll
        for (int h = 0; h < 2; ++h) { const i32x4 a = *(const LAS i32x4*)(tstart + 16 * h), b = *(const LAS i32x4*)(tstart + 16 * h + 4), c4 = *(const LAS i32x4*)(tstart + 16 * h + 8), d = *(const LAS i32x4*)(tstart + 16 * h + 12);
            e += ((a.x <= gt) + (a.y <= gt)) + ((a.z <= gt) + (a.w <= gt)) + ((b.x <= gt) + (b.y <= gt)) + ((b.z <= gt) + (b.w <= gt))
               + ((c4.x <= gt) + (c4.y <= gt)) + ((c4.z <= gt) + (c4.w <= gt)) + ((d.x <= gt) + (d.y <= gt)) + ((d.z <= gt) + (d.w <= gt)); }
        u.pm = __builtin_amdgcn_readfirstlane(gt); u.pn = __builtin_amdgcn_readfirstlane(ct); u.aux = __builtin_amdgcn_readfirstlane(e); return true;
    }
    DI unsigned a_row_raw(const pg8::Unit& u, int row) const {
        if (!gather) return (unsigned)(u.pm * 256 + row) << 2;
        int lr = (u.pm - tstart[u.aux]) * 256 + row; const int n = cnt[u.aux]; lr = lr < n ? lr : n - 1;
        return list[(size_t)u.aux * NTOK + lr];
    }
    DI unsigned a_row_fin(unsigned raw) const { return (raw >> 2) * 1024u; }
    DI const char* b_tile(const pg8::Unit& u) const { return Bt + ((size_t)__builtin_amdgcn_readfirstlane(u.aux * NCT + u.pn)) * 256 * 1024; }
};

#define EPI_ROWS(...) _Pragma("unroll") for (int ai = 0; ai < 2; ++ai) _Pragma("unroll") for (int m = 0; m < 4; ++m) { const int row = u.pm * 256 + ai * 128 + wr * 64 + m * 16 + fr; \
        _Pragma("unroll") for (int bj = 0; bj < 2; ++bj) { const int col = u.pn * 256 + bj * 128 + wc * 32 + 8 * fq; const f32x4 v0 = acc[ai][bj][m][0], v1 = acc[ai][bj][m][1]; __VA_ARGS__ } if (((ai * 4 + m) & 3) == 3) asm volatile("" ::: "memory"); }
DI u32x4 pack8(const f32x4 a, const f32x4 b) { u32x4 w; w.x = cvt_pk_bf16(a[0], a[1]); w.y = cvt_pk_bf16(a[2], a[3]); w.z = cvt_pk_bf16(b[0], b[1]); w.w = cvt_pk_bf16(b[2], b[3]); return w; }
DI void unpack8(const u32x4 w, f32x4& a, f32x4& b) { a = (f32x4){bf_lo(w.x), bf_hi(w.x), bf_lo(w.y), bf_hi(w.y)}; b = (f32x4){bf_lo(w.z), bf_hi(w.z), bf_lo(w.w), bf_hi(w.w)}; }

DI void unpack8_fp8(const u32x2 w, f32x4& a, f32x4& b) {
    const f32x2 a0 = __builtin_amdgcn_cvt_pk_f32_fp8((int)w.x, false), a1 = __builtin_amdgcn_cvt_pk_f32_fp8((int)w.x, true), b0 = __builtin_amdgcn_cvt_pk_f32_fp8((int)w.y, false), b1 = __builtin_amdgcn_cvt_pk_f32_fp8((int)w.y, true);
    a = (f32x4){a0.x, a0.y, a1.x, a1.y}; b = (f32x4){b0.x, b0.y, b1.x, b1.y};
}
constexpr float GATE_SCALE = 256.0f, T_SCALE = 16.0f, QLAT8_SCALE = 16.0f;
DI const unsigned char* gate8_ptr(const bf16_t* P, int row, int g) { return (const unsigned char*)P + (size_t)row * (NCOL * 2) + 6144 + g; }
struct EpiInProj {
    bf16_t* P; float* MISC;
    DI void init(f32x4 (&acc)[2][2][4][2], const pg8::Unit&, int, int) const {
#pragma unroll
        for (int a = 0; a < 2; ++a)
#pragma unroll
            for (int b = 0; b < 2; ++b)
#pragma unroll
                for (int m = 0; m < 4; ++m)
#pragma unroll
                    for (int n = 0; n < 2; ++n) acc[a][b][m][n] = (f32x4){0.f, 0.f, 0.f, 0.f};
    }
    DI void operator()(const f32x4 (&acc)[2][2][4][2], const pg8::Unit& u, int wr, int wc, int fr, int fq) const {
        const int pn = u.pn;
        const float ws = (pn < 4) ? (1.0f / WQL_SCALE) : (1.0f / WIN_SCALE);
        if (pn == 4) {
            EPI_ROWS( float* o = MISC + (size_t)row * 256 + (col - PC_MISC); *(f32x4*)o = v0 * ws; *(f32x4*)(o + 4) = v1 * ws; )
        } else if (pn >= 12) {
            EPI_ROWS( f32x4 a, b;
                _Pragma("unroll") for (int q = 0; q < 4; ++q) { a[q] = sigmoidf_(v0[q] * ws) * GATE_SCALE; b[q] = sigmoidf_(v1[q] * ws) * GATE_SCALE; }
                u32x2 w; w.x = pack_fp8x4(a[0], a[1], a[2], a[3]); w.y = pack_fp8x4(b[0], b[1], b[2], b[3]);
                *(u32x2*)(const_cast<unsigned char*>(gate8_ptr(P, row, col - PC_GA))) = w; )
        } else if (pn < 4) {
            const float sc = ws * QLAT8_SCALE;
            EPI_ROWS( const f32x4 a = v0 * sc, b = v1 * sc; u32x2 w; w.x = pack_fp8x4(a[0], a[1], a[2], a[3]); w.y = pack_fp8x4(b[0], b[1], b[2], b[3]);
                *(u32x2*)((unsigned char*)(P + (size_t)row * NCOL) + col) = w; )
        } else {
            const float sc = ((pn == 6 || pn == 7) ? SB_QSCALE : 1.0f) * ws;
            EPI_ROWS( *(u32x4*)(P + (size_t)row * NCOL + col) = pack8(v0 * sc, v1 * sc); )
        }
    }
};
struct EpiMergeA {
    const bf16_t* P; bf16_t* T;
    DI void init(f32x4 (&acc)[2][2][4][2], const pg8::Unit&, int, int) const {
#pragma unroll
        for (int a = 0; a < 2; ++a)
#pragma unroll
            for (int b = 0; b < 2; ++b)
#pragma unroll
                for (int m = 0; m < 4; ++m)
#pragma unroll
                    for (int n = 0; n < 2; ++n) acc[a][b][m][n] = (f32x4){0.f, 0.f, 0.f, 0.f};
    }
    DI void operator()(const f32x4 (&acc)[2][2][4][2], const pg8::Unit& u, int wr, int wc, int fr, int fq) const {
        EPI_ROWS( f32x4 ga, gb; unpack8_fp8(*(const u32x2*)gate8_ptr(P, row, col), ga, gb);
            const f32x4 t0 = v0 * ga * (T_SCALE / (WFA_SCALE * OLAT_SCALE * GATE_SCALE)), t1 = v1 * gb * (T_SCALE / (WFA_SCALE * OLAT_SCALE * GATE_SCALE));
            u32x2 w; w.x = pack_fp8x4(t0[0], t0[1], t0[2], t0[3]); w.y = pack_fp8x4(t1[0], t1[1], t1[2], t1[3]);
            *(u32x2*)((unsigned char*)T + (size_t)row * DM + col) = w; )
    }
};
struct EpiMergeB {
    const bf16_t* P; const bf16_t* T; unsigned char* MG;
    DI void init(f32x4 (&acc)[2][2][4][2], const pg8::Unit&, int, int) const {
#pragma unroll
        for (int a = 0; a < 2; ++a)
#pragma unroll
            for (int b = 0; b < 2; ++b)
#pragma unroll
                for (int m = 0; m < 4; ++m)
#pragma unroll
                    for (int n = 0; n < 2; ++n) acc[a][b][m][n] = (f32x4){0.f, 0.f, 0.f, 0.f};
    }
    DI void operator()(const f32x4 (&acc)[2][2][4][2], const pg8::Unit& u, int wr, int wc, int fr, int fq) const {
        EPI_ROWS( f32x4 ga, gb, ta, tb; unpack8_fp8(*(const u32x2*)gate8_ptr(P, row, 1024 + col), ga, gb); unpack8_fp8(*(const u32x2*)((const unsigned char*)T + (size_t)row * DM + col), ta, tb);
            const f32x4 m0 = (ta * (1.0f / T_SCALE) + v0 * ga * (1.0f / (WB_SCALE * OB_SCALE * GATE_SCALE))) * MG_SCALE, m1 = (tb * (1.0f / T_SCALE) + v1 * gb * (1.0f / (WB_SCALE * OB_SCALE * GATE_SCALE))) * MG_SCALE;
            u32x2 w; w.x = pack_fp8x4(m0[0], m0[1], m0[2], m0[3]); w.y = pack_fp8x4(m1[0], m1[1], m1[2], m1[3]);
            *(u32x2*)(MG + (size_t)row * DM + col) = w; )
    }
};
struct EpiWo {
    const void* X; const float* gate; bf16_t* Z; bool xbf;
    DI void init(f32x4 (&acc)[2][2][4][2], const pg8::Unit&, int, int) const {
#pragma unroll
        for (int a = 0; a < 2; ++a)
#pragma unroll
            for (int b = 0; b < 2; ++b)
#pragma unroll
                for (int m = 0; m < 4; ++m)
#pragma unroll
                    for (int n = 0; n < 2; ++n) acc[a][b][m][n] = (f32x4){0.f, 0.f, 0.f, 0.f};
    }
    DI void operator()(const f32x4 (&acc)[2][2][4][2], const pg8::Unit& u, int wr, int wc, int fr, int fq) const {
        f32x4 gq[2][2];
#pragma unroll
        for (int bj = 0; bj < 2; ++bj) { const float* g = gate + (size_t)((u.pm * 256) / SEQ) * 6144 + u.pn * 256 + bj * 128 + wc * 32 + 8 * fq; gq[bj][0] = *(const f32x4*)g; gq[bj][1] = *(const f32x4*)(g + 4); }
        EPI_ROWS( const f32x4 g0 = gq[bj][0], g1 = gq[bj][1]; f32x4 x0, x1;
            if (xbf) { const u32x4 xw = __builtin_nontemporal_load((const u32x4*)((const bf16_t*)X + (size_t)row * DM + col)); x0 = (f32x4){bf_lo(xw.x), bf_hi(xw.x), bf_lo(xw.y), bf_hi(xw.y)}; x1 = (f32x4){bf_lo(xw.z), bf_hi(xw.z), bf_lo(xw.w), bf_hi(xw.w)}; }
            else { const float* xp = (const float*)X + (size_t)row * DM + col; x0 = __builtin_nontemporal_load((const f32x4*)xp); x1 = __builtin_nontemporal_load((const f32x4*)(xp + 4)); }
            const f32x4 z0 = x0 * DN_ALPHA + g0 * v0 * (1.0f / (WO_SCALE * MG_SCALE)), z1 = x1 * DN_ALPHA + g1 * v1 * (1.0f / (WO_SCALE * MG_SCALE));
            *(u32x4*)(Z + (size_t)row * DM + col) = (u32x4){cvt_pk_bf16(z0.x, z0.y), cvt_pk_bf16(z0.z, z0.w), cvt_pk_bf16(z1.x, z1.y), cvt_pk_bf16(z1.z, z1.w)}; )
    }
};
struct EpiGateUp {
    const float* b_gu; unsigned char* ACT;
    DI void init(f32x4 (&acc)[2][2][4][2], const pg8::Unit& u, int wc, int fq) const {
        const int hc = u.pn * 128 + wc * 32 + 8 * fq;
        const float* ba = b_gu + (size_t)u.aux * 2048 + hc; const float* bu = ba + 1024;
        const f32x4 ba0 = *(const f32x4*)ba * WGU_SCALE, ba1 = *(const f32x4*)(ba + 4) * WGU_SCALE, bu0 = *(const f32x4*)bu * WGU_SCALE, bu1 = *(const f32x4*)(bu + 4) * WGU_SCALE;
#pragma unroll
        for (int a = 0; a < 2; ++a)
#pragma unroll
            for (int m = 0; m < 4; ++m) { acc[a][0][m][0] = ba0; acc[a][0][m][1] = ba1; acc[a][1][m][0] = bu0; acc[a][1][m][1] = bu1; }
    }
    DI void operator()(const f32x4 (&acc)[2][2][4][2], const pg8::Unit& u, int wr, int wc, int fr, int fq) const {
        const int hc = u.pn * 128 + wc * 32 + 8 * fq;
        constexpr float inv = 1.0f / WGU_SCALE;
#pragma unroll
        for (int ai = 0; ai < 2; ++ai)
#pragma unroll
            for (int m = 0; m < 4; ++m) { const int row = u.pm * 256 + ai * 128 + wr * 64 + m * 16 + fr;
                f32x4 r0, r1;
#pragma unroll
                for (int q = 0; q < 4; ++q) {
                    float a = fminf(acc[ai][0][m][0][q] * inv, 7.0f), uu = fminf(fmaxf(acc[ai][1][m][0][q] * inv, -7.0f), 7.0f);
                    r0[q] = (uu + 1.0f) * a * sigmoidf_(1.702f * a);
                    a = fminf(acc[ai][0][m][1][q] * inv, 7.0f); uu = fminf(fmaxf(acc[ai][1][m][1][q] * inv, -7.0f), 7.0f);
                    r1[q] = (uu + 1.0f) * a * sigmoidf_(1.702f * a); }
                u32x2 w; w.x = pack_fp8x4(r0[0], r0[1], r0[2], r0[3]); w.y = pack_fp8x4(r1[0], r1[1], r1[2], r1[3]);
                *(u32x2*)(ACT + (size_t)row * DEXP + hc) = w; }
    }
};
struct EpiDown {
    const float* b_dn; const unsigned* list; const float* gate; bf16_t* YS; const LAS int* tstart; const LAS int* cnt;
    DI void init(f32x4 (&acc)[2][2][4][2], const pg8::Unit& u, int wc, int fq) const {
#pragma unroll
        for (int bj = 0; bj < 2; ++bj) { const float* bp = b_dn + (size_t)u.aux * DM + u.pn * 256 + bj * 128 + wc * 32 + 8 * fq; const f32x4 b0 = *(const f32x4*)bp * WDN_SCALE, b1 = *(const f32x4*)(bp + 4) * WDN_SCALE;
#pragma unroll
            for (int a = 0; a < 2; ++a)
#pragma unroll
                for (int m = 0; m < 4; ++m) { acc[a][bj][m][0] = b0; acc[a][bj][m][1] = b1; } }
    }
    DI void operator()(const f32x4 (&acc)[2][2][4][2], const pg8::Unit& u, int wr, int wc, int fr, int fq) const {
        const int e = u.aux, lbase = (u.pm - tstart[e]) * 256, n = cnt[e];
        unsigned ent[8]; float g[8];
        const unsigned* lp = list + (size_t)e * NTOK; const float* gp = gate + (size_t)e * NTOK;
#pragma unroll
        for (int ai = 0; ai < 2; ++ai)
#pragma unroll
            for (int m = 0; m < 4; ++m) { int lr = lbase + ai * 128 + wr * 64 + m * 16 + fr; lr = lr < n ? lr : n - 1; ent[ai * 4 + m] = lp[lr]; g[ai * 4 + m] = gp[lr]; }
#pragma unroll
        for (int ai = 0; ai < 2; ++ai)
#pragma unroll
            for (int m = 0; m < 4; ++m) { const int lr = lbase + ai * 128 + wr * 64 + m * 16 + fr;
                if (lr < n) { const unsigned en = ent[ai * 4 + m]; const float gg = g[ai * 4 + m] * (1.0f / WDN_SCALE);
#pragma unroll
                    for (int bj = 0; bj < 2; ++bj) { const int col = u.pn * 256 + bj * 128 + wc * 32 + 8 * fq;
                        *(u32x4*)(YS + (size_t)en * DM + col) = pack8(acc[ai][bj][m][0] * gg, acc[ai][bj][m][1] * gg); } } }
    }
};

DI void phase_lnmod0(Ctx& F) {
    const int gw = F.vcu * 8 + F.wave, NGW = F.G * 8;
    const float* mod = (const float*)(F.ws + WS_MOD);
    unsigned char* H = (unsigned char*)(F.ws + WS_H);
    f32x4 vn[4];
    f32x4 SH[4], SC[4]; int bcur = -1;
    if (gw < NTOK) load_row(F.x + (size_t)gw * DM, F.lane, vn);
    for (int m = gw; m < NTOK; m += NGW) {
        f32x4 v[4];
#pragma unroll
        for (int j = 0; j < 4; ++j) v[j] = vn[j];
        if (m + NGW < NTOK) load_row(F.x + (size_t)(m + NGW) * DM, F.lane, vn);
        const int b = m / SEQ;
        if (b != bcur) { bcur = b; const float* mb = mod + (size_t)b * 6144;
#pragma unroll
            for (int j = 0; j < 4; ++j) { SH[j] = *((const GAS f32x4*)mb + F.lane + 64 * j); SC[j] = *((const GAS f32x4*)(mb + DM) + F.lane + 64 * j); } }
        float mean, rstd; ln_stats(v, mean, rstd);
#pragma unroll
        for (int j = 0; j < 4; ++j) { const f32x4 o = (v[j] - mean) * rstd * (SC[j] + 1.0f) + SH[j];
            *((GAS unsigned*)(H + (size_t)m * DM) + F.lane + 64 * j) = pack_fp8x4(o.x, o.y, o.z, o.w); }
    }
}
DI void phase_misc(Ctx& F, int l) {
    const int gw = F.vcu * 8 + F.wave, NGW = F.G * 8;
    const float* MISC = (const float*)(F.ws + WS_MISC);
    bf16_t* CKV = (bf16_t*)(F.ws + WS_CKV); bf16_t* KIDX = (bf16_t*)(F.ws + WS_KIDX); float* WIDX = (float*)(F.ws + WS_WIDX);
    const float idx_scale = 0.5f * 0.125f;
    const int g = F.lane >> 4, i = F.lane & 15;
    f32x4 gk[4];
#pragma unroll
    for (int k = 0; k < 4; ++k) gk[k] = (i < 8) ? *((const GAS f32x4*)(F.g_kv + (size_t)l * KVR + 16 * i) + k) : (f32x4){0.f, 0.f, 0.f, 0.f};
    f32x4 vn[4];
    if (gw * 4 < NTOK) {
#pragma unroll
        for (int k = 0; k < 4; ++k) vn[k] = __builtin_nontemporal_load((const GAS f32x4*)(MISC + (size_t)(gw * 4 + g) * 256 + 16 * i) + k);
    }
    for (int m0 = gw * 4; m0 < NTOK; m0 += NGW * 4) {
        const int m = m0 + g;
        f32x4 v[4];
#pragma unroll
        for (int k = 0; k < 4; ++k) v[k] = vn[k];
        if (m0 + NGW * 4 < NTOK) {
#pragma unroll
            for (int k = 0; k < 4; ++k) vn[k] = __builtin_nontemporal_load((const GAS f32x4*)(MISC + (size_t)(m + NGW * 4) * 256 + 16 * i) + k);
        }
        float s = 0.f;
#pragma unroll
        for (int k = 0; k < 4; ++k) s += (v[k].x * v[k].x + v[k].y * v[k].y) + (v[k].z * v[k].z + v[k].w * v[k].w);
        s += DPPF(s, 0xB1); s += DPPF(s, 0x4E); s += DPPF(s, 0x141);
        const float r = 1.0f / sqrtf(s * (1.f / KVR) + RMS_EPS);
        if (i < 8) { u32x4 w;
            const f32x4 e0 = v[0] * r * gk[0], e1 = v[1] * r * gk[1], e2 = v[2] * r * gk[2], e3 = v[3] * r * gk[3];
            w.x = pack_fp8x4(e0.x, e0.y, e0.z, e0.w); w.y = pack_fp8x4(e1.x, e1.y, e1.z, e1.w); w.z = pack_fp8x4(e2.x, e2.y, e2.z, e2.w); w.w = pack_fp8x4(e3.x, e3.y, e3.z, e3.w);
            *(GAS u32x4*)((unsigned char*)CKV + (size_t)m * KVR + 16 * i) = w; }
        else if (i < 12) { u32x4 w0, w1;
            w0.x = cvt_pk_bf16(v[0].x, v[0].y); w0.y = cvt_pk_bf16(v[0].z, v[0].w); w0.z = cvt_pk_bf16(v[1].x, v[1].y); w0.w = cvt_pk_bf16(v[1].z, v[1].w);
            w1.x = cvt_pk_bf16(v[2].x, v[2].y); w1.y = cvt_pk_bf16(v[2].z, v[2].w); w1.z = cvt_pk_bf16(v[3].x, v[3].y); w1.w = cvt_pk_bf16(v[3].z, v[3].w);
            GAS u32x4* o = (GAS u32x4*)(KIDX + (size_t)m * IDXD + 16 * (i - 8)); o[0] = w0; o[1] = w1; }
        else if (i == 12) { *((GAS f32x4*)(WIDX + (size_t)m * 4)) = v[0] * idx_scale; }
    }
}

DI void phase_ln_router(Ctx& F, int l) {
    const float* mod = (const float*)(F.ws + WS_MOD) + (size_t)l * 8 * 6144;
    const bf16_t* ZB = (const bf16_t*)(F.ws + WS_ZX); bf16_t* H = (bf16_t*)(F.ws + WS_H);
    const float* g1 = F.ln1_g + (size_t)l * DM; const float* b1 = F.ln1_b + (size_t)l * DM;
    const float* wr = F.w_router + (size_t)l * DM * NEXP; const float* br = F.b_router + (size_t)l * NEXP;
    LAS float* tile = (LAS float*)F.lds;
    LAS float* part = (LAS float*)F.lds;
    LAS float* logit = (LAS float*)(F.lds + 135168);
    LAS unsigned* rec_e = (LAS unsigned*)(F.lds + 140288);
    LAS float* rec_g = (LAS float*)(F.lds + 140288 + 8192);
    LAS unsigned* lcnt = (LAS unsigned*)(F.lds + 140288 + 16384);
    unsigned* list = (unsigned*)(F.ws + WS_LIST); float* gate = (float*)(F.ws + WS_GATEL);
    const int lane = F.lane, w = F.wave, hi = lane >> 5, r32 = lane & 31;
    const float* wrl = wr + (size_t)(128 * w + 4 * hi) * NEXP + r32;
    if (F.tid < 32) lcnt[F.tid] = 0u;
    __syncthreads();
    const int ntile = NTOK / 32; int nloc = 0;
    float bw[64];
#pragma unroll
    for (int s = 0; s < 64; ++s) bw[s] = wrl[(8 * (s >> 2) + (s & 3)) * NEXP];
    u32x2 nraw[4][4];
    if (F.vcu < ntile) {
#pragma unroll
        for (int rr = 0; rr < 4; ++rr)
#pragma unroll
            for (int j = 0; j < 4; ++j) nraw[rr][j] = *((const GAS u32x2*)(ZB + (size_t)(F.vcu * 32 + 4 * w + rr) * DM) + lane + 64 * j);
    }
    for (int tI = F.vcu; tI < ntile; tI += F.G, ++nloc) {
        const int tok0 = tI * 32;
        f32x4 vr[4][4];
#pragma unroll
        for (int rr = 0; rr < 4; ++rr)
#pragma unroll
            for (int j = 0; j < 4; ++j) { const u32x2 w_ = nraw[rr][j]; vr[rr][j] = (f32x4){bf_lo(w_.x), bf_hi(w_.x), bf_lo(w_.y), bf_hi(w_.y)}; }
#pragma unroll
        for (int rr = 0; rr < 4; ++rr) {
            const int row = tok0 + 4 * w + rr; const int b = row / SEQ;
            f32x4 (&v)[4] = vr[rr];
            float mean, rstd; ln_stats(v, mean, rstd);
#pragma unroll
            for (int j = 0; j < 4; ++j) { const f32x4 gg = *((const GAS f32x4*)g1 + lane + 64 * j), bb = *((const GAS f32x4*)b1 + lane + 64 * j);
                v[j] = (v[j] - mean) * rstd * gg + bb; }
            ln_stats(v, mean, rstd);
            const float* sh = mod + (size_t)b * 6144 + 3 * DM; const float* sc = sh + DM;
#pragma unroll
            for (int j = 0; j < 4; ++j) { const f32x4 s4 = *((const GAS f32x4*)sh + lane + 64 * j), c4 = *((const GAS f32x4*)sc + lane + 64 * j);
                const f32x4 o = (v[j] - mean) * rstd * (c4 + 1.0f) + s4;
                *((GAS unsigned*)((unsigned char*)H + (size_t)row * DM) + lane + 64 * j) = pack_fp8x4(o.x, o.y, o.z, o.w);
                *(LAS f32x4*)(tile + (4 * w + rr) * 1028 + 4 * lane + 256 * j) = o; }
        }
        __syncthreads();
        f32x16 acc;
#pragma unroll
        for (int i = 0; i < 16; ++i) acc[i] = 0.f;
#pragma unroll
        for (int s4 = 0; s4 < 16; ++s4) {
            const f32x4 a4 = *(const LAS f32x4*)(tile + r32 * 1028 + 128 * w + 8 * s4 + 4 * hi);
#pragma unroll
            for (int q = 0; q < 4; ++q) acc = __builtin_amdgcn_mfma_f32_32x32x2f32(a4[q], bw[4 * s4 + q], acc, 0, 0, 0);
        }
        __syncthreads();
#pragma unroll
        for (int i = 0; i < 16; ++i) part[(w * 32 + ((i & 3) + 8 * (i >> 2) + 4 * hi)) * 33 + r32] = acc[i];
        if (tI + F.G < ntile) {
#pragma unroll
            for (int rr = 0; rr < 4; ++rr)
#pragma unroll
                for (int j = 0; j < 4; ++j) nraw[rr][j] = *((const GAS u32x2*)(ZB + (size_t)((tI + F.G) * 32 + 4 * w + rr) * DM) + lane + 64 * j);
        }
        __syncthreads();
        for (int u = F.tid; u < 1024; u += 512) { const int t = u >> 5, e = u & 31; float s = br[e];
#pragma unroll
            for (int k = 0; k < 8; ++k) s += part[(k * 32 + t) * 33 + e];
            logit[t * 33 + e] = s; }
        __syncthreads();
        {
            int td_ = F.tid; asm volatile("" : "+v"(td_));
            const int t = td_ >> 4, j = td_ & 15;
            float v0 = logit[t * 33 + j], v1 = logit[t * 33 + 16 + j];
            float tv[4]; int te[4];
#pragma unroll
            for (int k = 0; k < 4; ++k) {
                const bool first = (v0 >= v1);
                const float lv = first ? v0 : v1; const int li = first ? j : j + 16;
                float m = lv;
                m = fmaxf(m, DPPF(m, 0xB1)); m = fmaxf(m, DPPF(m, 0x4E)); m = fmaxf(m, DPPF(m, 0x141)); m = fmaxf(m, DPPF(m, 0x140));
                int ci = (lv == m) ? li : 99;
                { int o_; o_ = __builtin_amdgcn_update_dpp(0, ci, 0xB1, 0xf, 0xf, false); ci = ci < o_ ? ci : o_; o_ = __builtin_amdgcn_update_dpp(0, ci, 0x4E, 0xf, 0xf, false); ci = ci < o_ ? ci : o_;
                  o_ = __builtin_amdgcn_update_dpp(0, ci, 0x141, 0xf, 0xf, false); ci = ci < o_ ? ci : o_; o_ = __builtin_amdgcn_update_dpp(0, ci, 0x140, 0xf, 0xf, false); ci = ci < o_ ? ci : o_; }
                tv[k] = m; te[k] = ci;
                if (ci == j) v0 = -INFINITY; if (ci == j + 16) v1 = -INFINITY;
            }
            const float e1 = __expf(tv[1] - tv[0]), e2 = __expf(tv[2] - tv[0]), e3 = __expf(tv[3] - tv[0]); const float inv = 1.0f / (1.0f + e1 + e2 + e3);
            if (j < 4) { const int ek = (j == 0) ? te[0] : (j == 1) ? te[1] : (j == 2) ? te[2] : te[3]; const float gk = ((j == 0) ? 1.0f : (j == 1) ? e1 : (j == 2) ? e2 : e3) * inv;
                const unsigned lr = atomicAdd((unsigned*)&lcnt[ek], 1u); rec_e[(nloc * 32 + t) * 4 + j] = (unsigned)ek | (lr << 8); rec_g[(nloc * 32 + t) * 4 + j] = gk; }
        }
        __syncthreads();
    }
    if (F.tid < 32) lcnt[32 + F.tid] = __hip_atomic_fetch_add((unsigned*)(F.ctl + CW_CNT + l * NEXP + F.tid), lcnt[F.tid], RLX_AGENT);
    __syncthreads();
    for (int u = F.tid; u < nloc * 128; u += 512) {
        const int tl = u >> 2, k = u & 3; const int tok = (F.vcu + (tl >> 5) * F.G) * 32 + (tl & 31);
        const unsigned re = rec_e[u]; const unsigned e = re & 255u, lr = re >> 8;
        list[(size_t)e * NTOK + lcnt[32 + e] + lr] = (unsigned)tok * 4u + (unsigned)k;
        gate[(size_t)e * NTOK + lcnt[32 + e] + lr] = rec_g[u];
    }
    __syncthreads();
}

DI void phase_final(Ctx& F, int l, float* xout, bool has_next) {
    const int gw = F.vcu * 8 + F.wave, NGW = F.G * 8;
    const float* mod = (const float*)(F.ws + WS_MOD) + (size_t)l * 8 * 6144;
    const float* modn = (const float*)(F.ws + WS_MOD) + (size_t)(l + 1) * 8 * 6144;
    const bf16_t* ZB = (const bf16_t*)(F.ws + WS_ZX); bf16_t* XB = (bf16_t*)(F.ws + WS_XB); const bf16_t* YS = (const bf16_t*)(F.ws + WS_YS); unsigned char* H = (unsigned char*)(F.ws + WS_H);
    const float* g1 = F.ln1_g + (size_t)l * DM; const float* b1 = F.ln1_b + (size_t)l * DM;
    const float* g2 = F.ln2_g + (size_t)l * DM; const float* b2 = F.ln2_b + (size_t)l * DM;
    u32x2 zn[4], yn[4][4];
#define FIN_LOAD(M) do { _Pragma("unroll") for (int j = 0; j < 4; ++j) { zn[j] = __builtin_nontemporal_load((const GAS u32x2*)(ZB + (size_t)(M) * DM) + F.lane + 64 * j); \
        _Pragma("unroll") for (int k = 0; k < 4; ++k) yn[j][k] = __builtin_nontemporal_load((const GAS u32x2*)(YS + ((size_t)(M) * 4 + k) * DM) + F.lane + 64 * j); } } while (0)
    if (gw < NTOK) FIN_LOAD(gw);
    f32x4 G1[4], B1[4], G2[4], B2[4];
#pragma unroll
    for (int j = 0; j < 4; ++j) { G1[j] = *((const GAS f32x4*)g1 + F.lane + 64 * j); B1[j] = *((const GAS f32x4*)b1 + F.lane + 64 * j); G2[j] = *((const GAS f32x4*)g2 + F.lane + 64 * j); B2[j] = *((const GAS f32x4*)b2 + F.lane + 64 * j); }
    f32x4 GT[4], SH[4], SC[4]; int bcur = -1;
    for (int m = gw; m < NTOK; m += NGW) {
        const int b = m / SEQ; f32x4 v[4], y[4];
        if (b != bcur) { bcur = b; const float* gt_ = mod + (size_t)b * 6144 + 5 * DM; const float* mb_ = modn + (size_t)b * 6144;
#pragma unroll
            for (int j = 0; j < 4; ++j) { GT[j] = *((const GAS f32x4*)gt_ + F.lane + 64 * j);
                if (has_next) { SH[j] = *((const GAS f32x4*)mb_ + F.lane + 64 * j); SC[j] = *((const GAS f32x4*)(mb_ + DM) + F.lane + 64 * j); } else { SH[j] = GT[j]; SC[j] = GT[j]; } } }
#pragma unroll
        for (int j = 0; j < 4; ++j) { v[j] = (f32x4){bf_lo(zn[j].x), bf_hi(zn[j].x), bf_lo(zn[j].y), bf_hi(zn[j].y)}; y[j] = (f32x4){0.f, 0.f, 0.f, 0.f};
#pragma unroll
            for (int k = 0; k < 4; ++k) { const u32x2 w = yn[j][k]; y[j] += (f32x4){bf_lo(w.x), bf_hi(w.x), bf_lo(w.y), bf_hi(w.y)}; } }
        if (m + NGW < NTOK) FIN_LOAD(m + NGW);
        float mean, rstd; ln_stats(v, mean, rstd);
#pragma unroll
        for (int j = 0; j < 4; ++j) v[j] = ((v[j] - mean) * rstd * G1[j] + B1[j]) * DN_ALPHA + GT[j] * y[j];
        ln_stats(v, mean, rstd);
#pragma unroll
        for (int j = 0; j < 4; ++j) {
            v[j] = (v[j] - mean) * rstd * G2[j] + B2[j];
            if (has_next) *((GAS u32x2*)(XB + (size_t)m * DM) + F.lane + 64 * j) = (u32x2){cvt_pk_bf16(v[j].x, v[j].y), cvt_pk_bf16(v[j].z, v[j].w)};
            else *((GAS f32x4*)(xout + (size_t)m * DM) + F.lane + 64 * j) = v[j]; }
        if (has_next) {
            ln_stats(v, mean, rstd);
#pragma unroll
            for (int j = 0; j < 4; ++j) { const f32x4 o = (v[j] - mean) * rstd * (SC[j] + 1.0f) + SH[j];
                *((GAS unsigned*)(H + (size_t)m * DM) + F.lane + 64 * j) = pack_fp8x4(o.x, o.y, o.z, o.w); } }
    }
#undef FIN_LOAD
}

typedef LAS const char* lds_cptr;
typedef short v4i16_t __attribute__((ext_vector_type(4)));
typedef int v2i_t __attribute__((ext_vector_type(2)));
DI s16x4 vtr(lds_cptr p) { return __builtin_bit_cast(s16x4, __builtin_amdgcn_ds_read_tr16_b64_v4i16((LAS v4i16_t*)p)); }
DI int crow(int r, int hi) { return (r & 3) + 8 * (r >> 2) + 4 * hi; }
DI float pair_sum(float v) { auto rr = __builtin_amdgcn_permlane32_swap(__float_as_uint(v), __float_as_uint(v), false, false); return __uint_as_float(rr[0]) + __uint_as_float(rr[1]); }

DI void sb_unit(Ctx& F, int u) {
    const bf16_t* P = (const bf16_t*)(F.ws + WS_P); bf16_t* OB = (bf16_t*)(F.ws + WS_OB);
    int lane_ = F.lane; asm volatile("" : "+v"(lane_));
    const int lane = lane_, r32 = lane & 31, hi = lane >> 5;
    LAS char* vs = (LAS char*)(F.lds + F.wave * 8192);
    const lds_cptr vp0 = (lds_cptr)vs + ((lane >> 4) & 1) * 32 + (lane & 3) * 8 + (4 * hi + ((lane & 15) >> 2)) * 64;
    {
        const int qblk = u & 255, h = (u >> 8) & 7, b = u >> 11, t0 = qblk * 32, t = t0 + r32;
        const size_t rowb = (size_t)b * SEQ;
        bf16x8 qr[4];
        { const bf16_t* Qp = P + (rowb + t) * NCOL + PC_QB + h * 64 + hi * 8;
#pragma unroll
          for (int d0 = 0; d0 < 4; ++d0) qr[d0] = *(const bf16x8*)(Qp + d0 * 16); }
        f32x16 o[2];
#pragma unroll
        for (int i = 0; i < 16; ++i) { o[0][i] = 0.f; o[1][i] = 0.f; }
        float carry = 0.f;
        bf16x8 kn0[4], kn1[4];
        { const bf16_t* Kp = P + (rowb + 64 * (t0 >> 6) + r32) * NCOL + PC_KB + h * 64 + hi * 8;
#pragma unroll
          for (int d0 = 0; d0 < 4; ++d0) { kn0[d0] = *(const bf16x8*)(Kp + d0 * 16); kn1[d0] = *(const bf16x8*)(Kp + (size_t)32 * NCOL + d0 * 16); } }
        for (int j = t0 >> 6; j >= 0; --j) {
            bf16x8 k0[4], k1[4];
#pragma unroll
            for (int d0 = 0; d0 < 4; ++d0) { k0[d0] = kn0[d0]; k1[d0] = kn1[d0]; }
            LDS_WAIT();
#pragma unroll
            for (int i = 0; i < 8; ++i) { const int row = 16 * (i & 3) + (lane >> 2), col = (i >> 2) * 32 + (lane & 3) * 8;
                __builtin_amdgcn_global_load_lds((const unsigned*)(P + (rowb + 64 * j + row) * NCOL + PC_VB + h * 64 + col), (LAS unsigned*)(vs + i * 1024), 16, 0, 0); }
            if (j > 0) { const bf16_t* Kp = P + (rowb + 64 * (j - 1) + r32) * NCOL + PC_KB + h * 64 + hi * 8;
#pragma unroll
                for (int d0 = 0; d0 < 4; ++d0) { kn0[d0] = *(const bf16x8*)(Kp + d0 * 16); kn1[d0] = *(const bf16x8*)(Kp + (size_t)32 * NCOL + d0 * 16); } }
            f32x16 p0, p1;
#pragma unroll
            for (int i = 0; i < 16; ++i) { p0[i] = 0.f; p1[i] = 0.f; }
#pragma unroll
            for (int d0 = 0; d0 < 4; ++d0) { p0 = __builtin_amdgcn_mfma_f32_32x32x16_bf16(k0[d0], qr[d0], p0, 0, 0, 0); p1 = __builtin_amdgcn_mfma_f32_32x32x16_bf16(k1[d0], qr[d0], p1, 0, 0, 0); }
            const bool diag = (64 * j + 63 >= t0);
            float L0[16], L1[16];
#pragma unroll
            for (int r = 0; r < 16; ++r) {
                const int s0 = 64 * j + crow(r, hi);
                float a = fmaxf(p0[r], 0.f) + fast_log2(1.0f + fast_exp2(-fabsf(p0[r])));
                float c = fmaxf(p1[r], 0.f) + fast_log2(1.0f + fast_exp2(-fabsf(p1[r])));
                if (diag) { if (s0 >= t) a = 0.f; if (s0 + 32 >= t) c = 0.f; }
                L0[r] = a; L1[r] = c; }
            float W[8], T[8];
#pragma unroll
            for (int g = 0; g < 4; ++g) { T[g] = (L0[4 * g] + L0[4 * g + 1]) + (L0[4 * g + 2] + L0[4 * g + 3]); T[4 + g] = (L1[4 * g] + L1[4 * g + 1]) + (L1[4 * g + 2] + L1[4 * g + 3]); }
#pragma unroll
            for (int g = 0; g < 8; ++g) W[g] = pair_sum(T[g]);
            float suf = carry;
#pragma unroll
            for (int g = 7; g >= 0; --g) {
                float off = suf + ((hi == 0) ? (W[g] - T[g]) : 0.f);
                if (g >= 4) {
#pragma unroll
                    for (int q = 3; q >= 0; --q) { const int r = 4 * (g - 4) + q; off += L1[r]; float a = fast_exp2(p1[r] - off); if (diag && (64 * j + 32 + crow(r, hi) >= t)) a = 0.f; p1[r] = a; }
                } else {
#pragma unroll
                    for (int q = 3; q >= 0; --q) { const int r = 4 * g + q; off += L0[r]; float a = fast_exp2(p0[r] - off); if (diag && (64 * j + crow(r, hi) >= t)) a = 0.f; p0[r] = a; }
                }
                suf += W[g];
            }
            carry = suf;
            asm volatile("s_waitcnt vmcnt(0)" ::: "memory");
            u32x4 pw[4];
#pragma unroll
            for (int q = 0; q < 4; ++q) { pw[0][q] = cvt_pk_bf16(p0[2 * q], p0[2 * q + 1]); pw[1][q] = cvt_pk_bf16(p0[8 + 2 * q], p0[8 + 2 * q + 1]); pw[2][q] = cvt_pk_bf16(p1[2 * q], p1[2 * q + 1]); pw[3][q] = cvt_pk_bf16(p1[8 + 2 * q], p1[8 + 2 * q + 1]); }
#pragma unroll
            for (int d0 = 0; d0 < 2; ++d0)
#pragma unroll
                for (int ks = 0; ks < 4; ++ks) {
                    const s16x4 lo = vtr(vp0 + d0 * 4096 + ks * 1024), hv = vtr(vp0 + d0 * 4096 + ks * 1024 + 512);
                    const bf16x8 vf = (bf16x8){lo[0], lo[1], lo[2], lo[3], hv[0], hv[1], hv[2], hv[3]};
                    o[d0] = __builtin_amdgcn_mfma_f32_32x32x16_bf16(__builtin_bit_cast(bf16x8, pw[ks]), vf, o[d0], 0, 0, 0); }
            if (!__any(carry < SB_STOP)) break;
        }
        unsigned char* Op = (unsigned char*)OB + (rowb + t0) * 512 + h * 64 + r32;
#pragma unroll
        for (int i = 0; i < 16; ++i) { const int row = crow(i, hi); const unsigned pk = pack_fp8x4(o[0][i] * OB_SCALE, o[1][i] * OB_SCALE, 0.f, 0.f);
            Op[(size_t)row * 512] = (unsigned char)(pk & 0xffu); Op[(size_t)row * 512 + 32] = (unsigned char)((pk >> 8) & 0xffu); }
    }
    LDS_WAIT();
}

constexpr int DS_HIST = 0;
constexpr int DS_STAGE = 0;
constexpr int CAND_CAP = 512;
constexpr int SAMPLE_STRIDE = 4;
constexpr int DS_CKEY = 0;
constexpr int DS_CIDX = 65536;
constexpr int DS_BMAP = 98304;
constexpr int DS_SEL = 131200;
constexpr int DS_SELCNT = DS_SEL + 16384;
constexpr int DS_STATE = DS_SELCNT + 128;
constexpr int DS_CSUM = DS_STATE + 8 * 128;
constexpr int DS_LUT = DS_CSUM + 2048;
constexpr int DS_WH = DS_LUT + 129 * 8 * 4;
constexpr int DS_END = DS_WH + 8 * 512;
static_assert(DS_END <= SCH_OFF, "DSA LDS map");
constexpr int STG_ROW = 272, STG_WAVE = 32 * STG_ROW;
static_assert(8 * STG_WAVE <= DS_BMAP && DS_BMAP + 32768 <= DS_SEL && DS_CIDX + 32 * CAND_CAP * 2 <= DS_BMAP, "overlay placement");
constexpr unsigned BIN_LO = 114u << 23, BIN_HI = BIN_LO + (16u << 23) - 1u;

DI unsigned f2key(float f) { const unsigned u = __float_as_uint(f + 0.0f); return u ^ ((unsigned)((int)u >> 31) | 0x80000000u); }

struct DsaQ {
    bf16x8 qf[4][4];
    float w[4];
};

DI unsigned bin11(unsigned key) {
    const bool pos = (key >> 31) != 0u;
    const unsigned mag = pos ? (key & 0x7fffffffu) : (~key & 0x7fffffffu);
    const unsigned mc = mag < BIN_LO ? BIN_LO : (mag > BIN_HI ? BIN_HI : mag);
    const unsigned mb = (mc - BIN_LO) >> 17;
    return pos ? 1024u + mb : 1023u - mb;
}
DI unsigned bin11_lokey(unsigned b) {
    if (b >= 1024u) { const unsigned mb = b - 1024u; return 0x80000000u | (mb == 0u ? 0u : BIN_LO + (mb << 17)); }
    const unsigned mb = 1023u - b; const unsigned mh = (mb == 1023u) ? 0x7fffffffu : BIN_LO + (mb << 17) + 0x1ffffu;
    return (~mh) & 0x7fffffffu;
}
template <int MODE, bool DIAG>
DI void dsa_pass_impl(Ctx& F, const DsaQ& Q, const bf16_t* KIDX, size_t rowb, int qb, int kstart, int kstep, unsigned pre, unsigned tieB, unsigned tieR, unsigned need) {
    int lane_ = F.lane; asm volatile("" : "+v"(lane_));
    const int lane = lane_, r32 = lane & 31, hi = lane >> 5;
    LAS unsigned* hist = (LAS unsigned*)(F.lds + DS_HIST) + r32 * 1025;
    LAS unsigned* bmap = (LAS unsigned*)(F.lds + DS_BMAP) + r32 * 256;
    LAS unsigned* ckey = (LAS unsigned*)(F.lds + DS_CKEY) + r32 * CAND_CAP;
    LAS unsigned short* cidx = (LAS unsigned short*)(F.lds + DS_CIDX) + r32 * CAND_CAP;
    LAS unsigned* ccnt = (LAS unsigned*)(F.lds + DS_STATE) + 192 + r32;
    const bf16_t* Kb = KIDX + (rowb + r32) * IDXD + hi * 8;
    bf16x8 kn[4];
    if (kstart <= qb) {
#pragma unroll
        for (int s = 0; s < 4; ++s) kn[s] = *(const bf16x8*)(Kb + (size_t)(32 * kstart) * IDXD + s * 16);
    }
    for (int kt = kstart; kt <= qb; kt += kstep) {
        bf16x8 kf[4];
#pragma unroll
        for (int s = 0; s < 4; ++s) kf[s] = kn[s];
        if (kt + kstep <= qb) {
#pragma unroll
            for (int s = 0; s < 4; ++s) kn[s] = *(const bf16x8*)(Kb + (size_t)(32 * (kt + kstep)) * IDXD + s * 16);
        }
        f32x16 sc;
#pragma unroll
        for (int i = 0; i < 16; ++i) sc[i] = 0.f;
#pragma unroll
        for (int h = 0; h < 4; ++h) {
            f32x16 d;
#pragma unroll
            for (int i = 0; i < 16; ++i) d[i] = 0.f;
#pragma unroll
            for (int s = 0; s < 4; ++s) d = __builtin_amdgcn_mfma_f32_32x32x16_bf16(kf[s], Q.qf[h][s], d, 0, 0, 0);
#pragma unroll
            for (int i = 0; i < 16; ++i) { const int db = (int)__float_as_uint(d[i]); sc[i] = __builtin_fmaf(__uint_as_float((unsigned)(db > 0 ? db : 0)), Q.w[h], sc[i]);
                asm("" : "+v"(sc[i])); }
        }
        constexpr bool diag = DIAG;
        int hi_ = lane >> 5, r32_ = lane & 31; asm volatile("" : "+v"(hi_), "+v"(r32_));
        if (MODE == 6) {
            const float thr = __uint_as_float((pre & 0x80000000u) ? (pre ^ 0x80000000u) : ~pre);
            const unsigned idxl = (unsigned)(32 * kt + 4 * hi_);
            unsigned slot[16];
#pragma unroll
            for (int i = 0; i < 16; ++i) { const bool valid = !diag || (crow(i, hi_) <= r32_); slot[i] = 0u;
                if (valid && sc[i] > thr) slot[i] = __hip_atomic_fetch_add(ccnt, 1u, __ATOMIC_RELAXED, __HIP_MEMORY_SCOPE_WORKGROUP); }
#pragma unroll
            for (int i = 0; i < 16; ++i) { const bool valid = !diag || (crow(i, hi_) <= r32_);
                if (valid && sc[i] > thr) { const unsigned s_ = slot[i] < (unsigned)CAND_CAP ? slot[i] : (unsigned)(CAND_CAP - 1);
                    ckey[s_] = __float_as_uint(sc[i]); cidx[s_] = (unsigned short)(idxl + (unsigned)((i & 3) + 8 * (i >> 2))); } }
            bool anyeq = false;
#pragma unroll
            for (int i = 0; i < 16; ++i) { const bool valid = !diag || (crow(i, hi_) <= r32_); anyeq = anyeq || (valid && sc[i] == thr); }
            if (__any(anyeq)) {
#pragma unroll
                for (int i = 0; i < 16; ++i) { const bool valid = !diag || (crow(i, hi_) <= r32_);
                    if (valid && sc[i] == thr) { const unsigned idx = idxl + (unsigned)((i & 3) + 8 * (i >> 2));
                        __hip_atomic_fetch_add(ccnt + 32, 1u, __ATOMIC_RELAXED, __HIP_MEMORY_SCOPE_WORKGROUP);
                        __hip_atomic_fetch_or(bmap + (idx >> 5), 1u << (idx & 31u), __ATOMIC_RELAXED, __HIP_MEMORY_SCOPE_WORKGROUP); } }
            }
            continue;
        }
#pragma unroll
        for (int g = 0; g < 4; ++g) {
            unsigned ord = 0u;
#pragma unroll
            for (int q = 0; q < 4; ++q) {
                const int i = 4 * g + q; const int kr = crow(i, hi);
                const bool valid = !diag || (kr <= r32);
                const unsigned idx = (unsigned)(32 * kt + kr);
                const unsigned key = f2key(sc[i]);
                if (MODE == 0) { if (valid) { const unsigned bin = key >> 21; __hip_atomic_fetch_add(hist + (bin >> 1), 1u << ((bin & 1u) * 16u), __ATOMIC_RELAXED, __HIP_MEMORY_SCOPE_WORKGROUP); } }
                else if (MODE == 1) { if (valid && (key >> 21) == pre) { const unsigned bin = (key >> 10) & 2047u; __hip_atomic_fetch_add(hist + (bin >> 1), 1u << ((bin & 1u) * 16u), __ATOMIC_RELAXED, __HIP_MEMORY_SCOPE_WORKGROUP); } }
                else if (MODE == 2) { if (valid && (key >> 10) == pre) { const unsigned bin = key & 1023u; __hip_atomic_fetch_add(hist + (bin >> 1), 1u << ((bin & 1u) * 16u), __ATOMIC_RELAXED, __HIP_MEMORY_SCOPE_WORKGROUP); } }
                else if (MODE == 3) { if (valid && need && key == pre) { const unsigned bin = idx >> 2; __hip_atomic_fetch_add(hist + (bin >> 1), 1u << ((bin & 1u) * 16u), __ATOMIC_RELAXED, __HIP_MEMORY_SCOPE_WORKGROUP); } }
                else if (MODE == 4) {
                    const bool tie = valid && (key == pre);
                    const unsigned grp = idx >> 2;
                    const bool take = valid && ((key > pre) || (tie && (grp < tieB || (grp == tieB && ord < tieR))));
                    if (tie) ++ord;
                    if (take) __hip_atomic_fetch_or(bmap + (idx >> 5), 1u << (idx & 31u), __ATOMIC_RELAXED, __HIP_MEMORY_SCOPE_WORKGROUP);
                }
                else if (MODE == 5) { if (valid) { const unsigned bin = bin11(key); __hip_atomic_fetch_add(hist + (bin >> 1), 1u << ((bin & 1u) * 16u), __ATOMIC_RELAXED, __HIP_MEMORY_SCOPE_WORKGROUP); } }
                else { }
            }
        }
    }
}

template <int MODE>
DI void dsa_pass(Ctx& F, const DsaQ& Q, const bf16_t* KIDX, size_t rowb, int qb, unsigned pre, unsigned tieB, unsigned tieR, unsigned need) {
    const int kstart = (MODE == 5) ? SAMPLE_STRIDE * F.wave : F.wave, kstep = (MODE == 5) ? 8 * SAMPLE_STRIDE : 8;
    dsa_pass_impl<MODE, false>(F, Q, KIDX, rowb, qb - 1, kstart, kstep, pre, tieB, tieR, need);
    if (qb >= kstart && ((qb - kstart) % kstep) == 0) dsa_pass_impl<MODE, true>(F, Q, KIDX, rowb, qb, qb, kstep, pre, tieB, tieR, need);
}

template <int MODE>
DI void dsa_scan(Ctx& F) {
    LAS unsigned* hist = (LAS unsigned*)(F.lds + DS_HIST);
    LAS unsigned* st = (LAS unsigned*)(F.lds + DS_STATE);
    LAS unsigned* csum = (LAS unsigned*)(F.lds + DS_CSUM);
    const int q = F.tid & 31, j = F.tid >> 5;
    LAS unsigned* hw = hist + q * 1025 + 64 * j;
    __syncthreads();
    unsigned s = 0u;
#pragma unroll 8
    for (int w = 0; w < 64; ++w) { const unsigned v = hw[w]; s += (v & 0xffffu) + (v >> 16); }
    csum[q * 16 + j] = s;
    __syncthreads();
    const unsigned rank = st[32 + q];
    const bool active = (MODE != 3) || (st[128 + q] != 0u);
    unsigned before = 0u;
    { const u32x4 c0 = *(const LAS u32x4*)(csum + q * 16), c1 = *(const LAS u32x4*)(csum + q * 16 + 4), c2 = *(const LAS u32x4*)(csum + q * 16 + 8), c3 = *(const LAS u32x4*)(csum + q * 16 + 12);
      const unsigned cs[16] = {c0.x, c0.y, c0.z, c0.w, c1.x, c1.y, c1.z, c1.w, c2.x, c2.y, c2.z, c2.w, c3.x, c3.y, c3.z, c3.w};
#pragma unroll
      for (int k = 0; k < 16; ++k) before += ((MODE != 3) ? (k > j) : (k < j)) ? cs[k] : 0u; }
    if (active && before < rank && rank <= before + s) {
        unsigned c = before, bin = 0u, cb = 0u, m = 0u; bool found = false;
        if (MODE != 3) {
#pragma unroll 1
            for (int w0 = 60; w0 >= 0 && !found; w0 -= 4) {
                const unsigned vv[4] = {hw[w0 + 3], hw[w0 + 2], hw[w0 + 1], hw[w0]};
#pragma unroll
                for (int e = 0; e < 4; ++e) if (!found) { const int w = w0 + 3 - e; const unsigned v = vv[e]; const unsigned h1 = v >> 16, h0 = v & 0xffffu;
                    if (c + h1 >= rank) { bin = 128u * j + 2u * w + 1u; cb = c; m = h1; found = true; }
                    else { c += h1; if (c + h0 >= rank) { bin = 128u * j + 2u * w; cb = c; m = h0; found = true; } else c += h0; } } }
        } else {
#pragma unroll 1
            for (int w = 0; w < 64 && !found; ++w) { const unsigned v = hw[w]; const unsigned h1 = v >> 16, h0 = v & 0xffffu;
                if (c + h0 >= rank) { bin = 128u * j + 2u * w; cb = c; m = h0; found = true; }
                else { c += h0; if (c + h1 >= rank) { bin = 128u * j + 2u * w + 1u; cb = c; m = h1; found = true; } else c += h1; } }
        }
        const unsigned r = rank - cb;
        if (MODE == 5) { st[q] = bin11_lokey(bin); }
        else if (MODE == 0) { st[q] = bin; st[32 + q] = r; }
        else if (MODE == 1) { st[q] = (st[q] << 11) | bin; st[32 + q] = r; }
        else if (MODE == 2) { st[q] = (st[q] << 10) | bin; st[32 + q] = r; const unsigned nd = (r < m) ? 1u : 0u; st[128 + q] = nd; st[64 + q] = 0x7fffffffu; st[96 + q] = 0u; if (nd) st[160] = 1u; }
        else { st[64 + q] = bin; st[96 + q] = r; }
    }
    __syncthreads();
#pragma unroll 8
    for (int w = 0; w < 64; ++w) hw[w] = 0u;
    if (j == 15) hw[64] = 0u;
    __syncthreads();
}

template <int DUMMY>
DI void dsa_attend(Ctx& F, const bf16_t* P, const bf16_t* CKV, bf16_t* OLAT, size_t rowb, int t, int qi) {
    int lane_ = F.lane; asm volatile("" : "+v"(lane_));
    const int lane = lane_, hd = lane & 15, g = lane >> 4;
    LAS unsigned char* stg = F.lds + DS_STAGE + F.wave * STG_WAVE;
    const LAS unsigned short* sel = (const LAS unsigned short*)(F.lds + DS_SEL) + qi * 256;
    const LAS float* lut = (const LAS float*)(F.lds + DS_LUT);
    int cnt = (int)((const LAS unsigned*)(F.lds + DS_SELCNT))[qi]; cnt = cnt > 256 ? 256 : cnt;
    bf16x8 ql[4];
    { const bf16_t* qp = P + (rowb + t) * NCOL + PC_QLAT + (hd & 7) * 128 + 8 * g;
#pragma unroll
      for (int ks = 0; ks < 4; ++ks) { ql[ks] = *(const bf16x8*)(qp + 32 * ks); if (hd >= 8) ql[ks] = (bf16x8){0, 0, 0, 0, 0, 0, 0, 0}; } }
    f32x4 O[8];
#pragma unroll
    for (int c = 0; c < 8; ++c) O[c] = (f32x4){0.f, 0.f, 0.f, 0.f};
    float m_run = -1e30f, l_run = 0.f;
    const char* cbase = (const char*)(CKV + rowb * KVR);
    const unsigned lo16 = (unsigned)hd * 16u;
    const LAS unsigned short* selp = sel + 4 * g;
    unsigned ka[8], kb[8]; u32x4 gva[8], gvb[8];
#define ATT_KEYS(K, C0) do { _Pragma("unroll") for (int a = 0; a < 2; ++a) { const u32x2 w_ = *(const LAS u32x2*)(selp + (C0) + 16 * a); K[4 * a] = w_.x & 0xffffu; K[4 * a + 1] = w_.x >> 16; K[4 * a + 2] = w_.y & 0xffffu; K[4 * a + 3] = w_.y >> 16; } } while (0)
#define ATT_LOAD(GV, K) do { _Pragma("unroll") for (int j = 0; j < 8; ++j) GV[j] = *(const u32x4*)(cbase + ((DUMMY == 2 ? 0u : K[j]) * 256u + lo16)); } while (0)
#define ATT_CHUNK(GV, K, KN, GVN, C0) do { \
        LDS_WAIT(); \
        _Pragma("unroll") for (int j = 0; j < 8; ++j) *(LAS u32x4*)(stg + (16 * (j >> 2) + 4 * g + (j & 3)) * STG_ROW + lo16) = GV[j]; \
        unsigned kc[8]; _Pragma("unroll") for (int j = 0; j < 8; ++j) kc[j] = K[j]; \
        if ((C0) + 64 < cnt) { ATT_KEYS(KN, (C0) + 64); ATT_LOAD(GVN, KN); } \
        f32x4 S[2]; \
        _Pragma("unroll") for (int a = 0; a < 2; ++a) { S[a] = (f32x4){0.f, 0.f, 0.f, 0.f}; \
            _Pragma("unroll") for (int ks = 0; ks < 4; ++ks) { const bf16x8 cf = *(const LAS bf16x8*)(stg + (16 * a + hd) * STG_ROW + (32 * ks + 8 * g) * 2); \
                S[a] = __builtin_amdgcn_mfma_f32_16x16x32_bf16(cf, ql[ks], S[a], 0, 0, 0); } } \
        float mx = -1e30f; \
        _Pragma("unroll") for (int a = 0; a < 2; ++a) _Pragma("unroll") for (int i = 0; i < 4; ++i) { const int slot = (C0) + 16 * a + 4 * g + i; \
                int dd = t - (int)kc[4 * a + i]; dd = dd < 0 ? 0 : (dd > 128 ? 128 : dd); \
                float v = S[a][i] + lut[dd * 8 + (hd & 7)]; v = (slot < cnt) ? v : -1e30f; S[a][i] = v; mx = fmaxf(mx, v); } \
        if (__any(mx > m_run + 8.0f)) {     \
            mx = fmaxf(mx, __shfl_xor(mx, 16)); mx = fmaxf(mx, __shfl_xor(mx, 32)); \
            const float m_new = fmaxf(m_run, mx); const float alpha = fast_exp2((m_run - m_new) * LOG2E); \
            l_run *= alpha; m_run = m_new; \
            float al[4]; _Pragma("unroll") for (int i = 0; i < 4; ++i) al[i] = __shfl(alpha, 4 * g + i); \
            _Pragma("unroll") for (int c = 0; c < 8; ++c) _Pragma("unroll") for (int i = 0; i < 4; ++i) O[c][i] *= al[i]; \
        } \
        float ps = 0.f; \
        _Pragma("unroll") for (int a = 0; a < 2; ++a) _Pragma("unroll") for (int i = 0; i < 4; ++i) { const float p = fast_exp2((S[a][i] - m_run) * LOG2E); S[a][i] = p; ps += p; } \
        l_run += ps; \
        u32x4 pw; pw.x = cvt_pk_bf16(S[0][0], S[0][1]); pw.y = cvt_pk_bf16(S[0][2], S[0][3]); pw.z = cvt_pk_bf16(S[1][0], S[1][1]); pw.w = cvt_pk_bf16(S[1][2], S[1][3]); \
        const lds_cptr tb = (lds_cptr)stg + (4 * g + (hd >> 2)) * STG_ROW + 8 * (hd & 3); \
        _Pragma("unroll") for (int c = 0; c < 8; ++c) { \
            const s16x4 lo = vtr(tb + 32 * c), hv = vtr(tb + 16 * STG_ROW + 32 * c); \
            const bf16x8 cf = (bf16x8){lo[0], lo[1], lo[2], lo[3], hv[0], hv[1], hv[2], hv[3]}; \
            O[c] = __builtin_amdgcn_mfma_f32_16x16x32_bf16(__builtin_bit_cast(bf16x8, pw), cf, O[c], 0, 0, 0); } \
    } while (0)
    ATT_KEYS(ka, 0); ATT_LOAD(gva, ka);
    if (32 < cnt) { ATT_KEYS(kb, 32); ATT_LOAD(gvb, kb); }
    for (int c0 = 0; c0 < cnt; c0 += 64) {
        ATT_CHUNK(gva, ka, ka, gva, c0);
        if (c0 + 32 < cnt) ATT_CHUNK(gvb, kb, kb, gvb, c0 + 32);
    }
#undef ATT_KEYS
#undef ATT_LOAD
#undef ATT_CHUNK
    l_run += __shfl_xor(l_run, 16); l_run += __shfl_xor(l_run, 32);
    const float inv = 1.0f / l_run;
    float iv[4];
#pragma unroll
    for (int i = 0; i < 4; ++i) iv[i] = __shfl(inv, 4 * g + i);
    if (DUMMY) {
#pragma unroll
        for (int c = 0; c < 8; ++c) asm volatile("" :: "v"(O[c][0] * iv[0]), "v"(O[c][1] * iv[1]), "v"(O[c][2] * iv[2]), "v"(O[c][3] * iv[3]));
    } else if (g < 2) {
        unsigned char* op = (unsigned char*)OLAT + (rowb + t) * 1024 + hd;
#pragma unroll
        for (int c = 0; c < 8; ++c) { const unsigned pk = pack_fp8x4(O[c][0] * iv[0] * OLAT_SCALE, O[c][1] * iv[1] * OLAT_SCALE, O[c][2] * iv[2] * OLAT_SCALE, O[c][3] * iv[3] * OLAT_SCALE);
#pragma unroll
            for (int i = 0; i < 4; ++i) op[(4 * g + i) * 128 + 16 * c] = (unsigned char)((pk >> (8 * i)) & 0xffu); }
    }
}

constexpr int ST8_ROW = 144;
constexpr float QL8_SCALE = 16.0f, P8_SCALE = 32.0f;
static_assert(QL8_SCALE == QLAT8_SCALE, "q_lat fp8 scale: in-projection epilogue and sparse attention agree");
DI long mk64(unsigned lo, unsigned hi) { return (long)(((unsigned long long)hi << 32) | (unsigned long long)lo); }
DI void dsa_attend8(Ctx& F, const bf16_t* P, const unsigned char* CKV8, bf16_t* OLAT, size_t rowb, int t, int qi) {
    int lane_ = F.lane; asm volatile("" : "+v"(lane_));
    const int lane = lane_, hd = lane & 15, g = lane >> 4;
    LAS unsigned char* stg = F.lds + DS_STAGE + F.wave * STG_WAVE;
    const LAS unsigned short* sel = (const LAS unsigned short*)(F.lds + DS_SEL) + qi * 256;
    const LAS float* lut = (const LAS float*)(F.lds + DS_LUT);
    int cnt = (int)((const LAS unsigned*)(F.lds + DS_SELCNT))[qi]; cnt = cnt > 256 ? 256 : cnt;
    long qf8[4];
    { const bf16_t* qp = P + (rowb + t) * NCOL + PC_QLAT + (hd & 7) * 128 + 8 * g;
#pragma unroll
      for (int ks = 0; ks < 4; ++ks) { const u32x4 w = *(const u32x4*)(qp + 32 * ks);
          const unsigned lo = pack_fp8x4(bf_lo(w.x) * QL8_SCALE, bf_hi(w.x) * QL8_SCALE, bf_lo(w.y) * QL8_SCALE, bf_hi(w.y) * QL8_SCALE), hi = pack_fp8x4(bf_lo(w.z) * QL8_SCALE, bf_hi(w.z) * QL8_SCALE, bf_lo(w.w) * QL8_SCALE, bf_hi(w.w) * QL8_SCALE);
          qf8[ks] = (hd < 8) ? mk64(lo, hi) : 0L; } }
    f32x4 O[8];
#pragma unroll
    for (int c = 0; c < 8; ++c) O[c] = (f32x4){0.f, 0.f, 0.f, 0.f};
    float m_run = -1e30f, l_run = 0.f;
    const unsigned char* cbase = CKV8 + rowb * KVR;
    const int grow = lane >> 3; const unsigned gl16 = (unsigned)(lane & 7) * 16u;
    const LAS unsigned short* selp = sel + 4 * g;
    unsigned ka[4], kb[4]; u32x4 gva[4], gvb[4];
#define A8_KEYS(K, C0) do { _Pragma("unroll") for (int i = 0; i < 4; ++i) K[i] = (unsigned)sel[(C0) + 8 * i + grow]; } while (0)
#define A8_LOAD(GV, K) do { _Pragma("unroll") for (int i = 0; i < 4; ++i) GV[i] = *(const u32x4*)(cbase + (K[i] * 128u + gl16)); } while (0)
#define A8_CHUNK(GV, K, C0) do { \
        LDS_WAIT(); \
        _Pragma("unroll") for (int i = 0; i < 4; ++i) { const int s_ = 8 * i + grow; *(LAS u32x4*)(stg + (8 * ((s_ >> 2) & 3) + 4 * (s_ >> 4) + (s_ & 3)) * ST8_ROW + gl16) = GV[i]; } \
        unsigned kc[8]; \
        _Pragma("unroll") for (int a = 0; a < 2; ++a) { const u32x2 w_ = *(const LAS u32x2*)(selp + (C0) + 16 * a); kc[4 * a] = w_.x & 0xffffu; kc[4 * a + 1] = w_.x >> 16; kc[4 * a + 2] = w_.y & 0xffffu; kc[4 * a + 3] = w_.y >> 16; } \
        if ((C0) + 64 < cnt) { A8_KEYS(K, (C0) + 64); A8_LOAD(GV, K); } \
        f32x4 S[2]; \
        _Pragma("unroll") for (int a = 0; a < 2; ++a) { S[a] = (f32x4){0.f, 0.f, 0.f, 0.f}; \
            _Pragma("unroll") for (int ks = 0; ks < 4; ++ks) { const u32x2 af = *(const LAS u32x2*)(stg + (8 * (hd >> 2) + 4 * a + (hd & 3)) * ST8_ROW + 32 * ks + 8 * g); \
                S[a] = __builtin_amdgcn_mfma_f32_16x16x32_fp8_fp8(mk64(af.x, af.y), qf8[ks], S[a], 0, 0, 0); } } \
        float mx = -1e30f; \
        _Pragma("unroll") for (int a = 0; a < 2; ++a) _Pragma("unroll") for (int i = 0; i < 4; ++i) { const int slot = (C0) + 16 * a + 4 * g + i; \
                int dd = t - (int)kc[4 * a + i]; dd = dd < 0 ? 0 : (dd > 128 ? 128 : dd); \
                float v = S[a][i] * (1.0f / QL8_SCALE) + lut[dd * 8 + (hd & 7)]; v = (slot < cnt) ? v : -1e30f; S[a][i] = v; mx = fmaxf(mx, v); } \
        if (__any(mx > m_run + 2.0f)) {     \
            mx = fmaxf(mx, __shfl_xor(mx, 16)); mx = fmaxf(mx, __shfl_xor(mx, 32)); \
            const float m_new = fmaxf(m_run, mx); const float alpha = fast_exp2((m_run - m_new) * LOG2E); \
            l_run *= alpha; m_run = m_new; \
            float al[4]; _Pragma("unroll") for (int i = 0; i < 4; ++i) al[i] = __shfl(alpha, 4 * g + i); \
            _Pragma("unroll") for (int c = 0; c < 8; ++c) _Pragma("unroll") for (int i = 0; i < 4; ++i) O[c][i] *= al[i]; \
        } \
        float ps = 0.f; \
        _Pragma("unroll") for (int a = 0; a < 2; ++a) _Pragma("unroll") for (int i = 0; i < 4; ++i) { const float p = fast_exp2((S[a][i] - m_run) * LOG2E); S[a][i] = p * P8_SCALE; ps += p; } \
        l_run += ps; \
        const long pw = mk64(pack_fp8x4(S[0][0], S[0][1], S[0][2], S[0][3]), pack_fp8x4(S[1][0], S[1][1], S[1][2], S[1][3])); \
        const LAS unsigned char* tb = stg + (8 * g + (hd >> 1)) * ST8_ROW + 8 * (hd & 1); \
        _Pragma("unroll") for (int c = 0; c < 8; ++c) { \
            const v2i_t cf = __builtin_amdgcn_ds_read_tr8_b64_v2i32((LAS v2i_t*)(tb + 16 * c)); \
            O[c] = __builtin_amdgcn_mfma_f32_16x16x32_fp8_fp8(pw, mk64((unsigned)cf.x, (unsigned)cf.y), O[c], 0, 0, 0); } \
    } while (0)
    A8_KEYS(ka, 0); A8_LOAD(gva, ka);
    if (32 < cnt) { A8_KEYS(kb, 32); A8_LOAD(gvb, kb); }
    for (int c0 = 0; c0 < cnt; c0 += 64) {
        A8_CHUNK(gva, ka, c0);
        if (c0 + 32 < cnt) A8_CHUNK(gvb, kb, c0 + 32);
    }
#undef A8_KEYS
#undef A8_LOAD
#undef A8_CHUNK
    l_run += __shfl_xor(l_run, 16); l_run += __shfl_xor(l_run, 32);
    const float inv = (OLAT_SCALE / P8_SCALE) / l_run;
    float iv[4];
#pragma unroll
    for (int i = 0; i < 4; ++i) iv[i] = __shfl(inv, 4 * g + i);
    if (g < 2) {
        unsigned char* op = (unsigned char*)OLAT + (rowb + t) * 1024 + hd;
#pragma unroll
        for (int c = 0; c < 8; ++c) { const unsigned pk = pack_fp8x4(O[c][0] * iv[0], O[c][1] * iv[1], O[c][2] * iv[2], O[c][3] * iv[3]);
#pragma unroll
            for (int i = 0; i < 4; ++i) op[(4 * g + i) * 128 + 16 * c] = (unsigned char)((pk >> (8 * i)) & 0xffu); }
    }
}

constexpr int ST8_Q = 32 * ST8_ROW, ST8_WAVE = 2 * ST8_Q;
static_assert(8 * ST8_WAVE <= DS_BMAP, "fp8 stage overlay");
template <int NZ>
DI void dsa_attend8z(Ctx& F, const bf16_t* P, const unsigned char* CKV8, bf16_t* OLAT, size_t rowb, int tq0, int qi0) {
    int lane_ = F.lane; asm volatile("" : "+v"(lane_));
    const int lane = lane_, hd = lane & 15, g = lane >> 4;
    LAS unsigned char* stg0 = F.lds + DS_STAGE + F.wave * ST8_WAVE;
    const LAS unsigned short* sel0 = (const LAS unsigned short*)(F.lds + DS_SEL) + qi0 * 256;
    const LAS float* lut = (const LAS float*)(F.lds + DS_LUT);
    const float farb = lut[128 * 8 + (hd & 7)];
    int cnt[NZ]; int cmax = 0;
#pragma unroll
    for (int z = 0; z < NZ; ++z) { int c_ = (int)((const LAS unsigned*)(F.lds + DS_SELCNT))[qi0 + z]; c_ = c_ > 256 ? 256 : c_; cnt[z] = c_; cmax = c_ > cmax ? c_ : cmax; }
    i32x8 qf8[NZ];
#pragma unroll
    for (int z = 0; z < NZ; ++z) { const unsigned char* qp = (const unsigned char*)(P + (rowb + tq0 + z) * NCOL) + PC_QLAT + (hd & 7) * 128 + 32 * g;
        const u32x4 w0 = *(const u32x4*)qp, w1 = *(const u32x4*)(qp + 16);
        qf8[z][0] = (hd < 8) ? (int)w0.x : 0; qf8[z][1] = (hd < 8) ? (int)w0.y : 0; qf8[z][2] = (hd < 8) ? (int)w0.z : 0; qf8[z][3] = (hd < 8) ? (int)w0.w : 0;
        qf8[z][4] = (hd < 8) ? (int)w1.x : 0; qf8[z][5] = (hd < 8) ? (int)w1.y : 0; qf8[z][6] = (hd < 8) ? (int)w1.z : 0; qf8[z][7] = (hd < 8) ? (int)w1.w : 0; }
    f32x4 O[NZ][8];
    float m_run[NZ], l_run[NZ];
#pragma unroll
    for (int z = 0; z < NZ; ++z) { m_run[z] = -1e30f; l_run[z] = 0.f;
#pragma unroll
        for (int c = 0; c < 8; ++c) O[z][c] = (f32x4){0.f, 0.f, 0.f, 0.f}; }
    const unsigned char* cbase = CKV8 + rowb * KVR;
    const int grow = lane >> 3; const unsigned gl16 = (unsigned)(lane & 7) * 16u;
    const int wrow = (8 * (grow & 3) + 4 * (grow >> 2)) * ST8_ROW + (int)gl16;
    u32x4 gv[NZ][4];
#define A8Z_LOAD(C0) do { _Pragma("unroll") for (int z = 0; z < NZ; ++z) { const u32x2 kw_ = *(const LAS u32x2*)(sel0 + z * 256 + (C0) + 4 * grow); \
        gv[z][0] = *(const u32x4*)(cbase + ((kw_.x & 0xffffu) * 128u + gl16)); gv[z][1] = *(const u32x4*)(cbase + ((kw_.x >> 16) * 128u + gl16)); \
        gv[z][2] = *(const u32x4*)(cbase + ((kw_.y & 0xffffu) * 128u + gl16)); gv[z][3] = *(const u32x4*)(cbase + ((kw_.y >> 16) * 128u + gl16)); } } while (0)
    A8Z_LOAD(0);
#pragma unroll 1
    for (int c0 = 0; c0 < cmax; c0 += 32) {
        LDS_WAIT();
#pragma unroll
        for (int z = 0; z < NZ; ++z)
#pragma unroll
            for (int i = 0; i < 4; ++i) *(LAS u32x4*)(stg0 + z * ST8_Q + wrow + i * ST8_ROW) = gv[z][i];
        if (c0 + 32 < cmax) A8Z_LOAD(c0 + 32);
        f32x4 S[NZ][2];
#pragma unroll
        for (int z = 0; z < NZ; ++z) {
            const LAS unsigned char* ar = stg0 + z * ST8_Q + (8 * (hd >> 2) + (hd & 3)) * ST8_ROW + 32 * g;
            const i32x8 a0 = __builtin_shufflevector(*(const LAS i32x4*)ar, *(const LAS i32x4*)(ar + 16), 0, 1, 2, 3, 4, 5, 6, 7);
            const i32x8 a1 = __builtin_shufflevector(*(const LAS i32x4*)(ar + 4 * ST8_ROW), *(const LAS i32x4*)(ar + 4 * ST8_ROW + 16), 0, 1, 2, 3, 4, 5, 6, 7);
            asm volatile("v_mfma_f32_16x16x128_f8f6f4 %0, %2, %4, 0\n\tv_mfma_f32_16x16x128_f8f6f4 %1, %3, %4, 0\n\ts_nop 15\n\ts_nop 7"
                         : "=&v"(S[z][0]), "=&v"(S[z][1]) : "v"(a0), "v"(a1), "v"(qf8[z]));
        }
        float mx[NZ];
#pragma unroll
        for (int z = 0; z < NZ; ++z) { mx[z] = -1e30f;
            unsigned kc[8];
#pragma unroll
            for (int a = 0; a < 2; ++a) { const u32x2 w_ = *(const LAS u32x2*)(sel0 + z * 256 + 4 * g + c0 + 16 * a); kc[4 * a] = w_.x & 0xffffu; kc[4 * a + 1] = w_.x >> 16; kc[4 * a + 2] = w_.y & 0xffffu; kc[4 * a + 3] = w_.y >> 16; }
            bool nearb = false;
#pragma unroll
            for (int j = 0; j < 8; ++j) nearb = nearb || ((tq0 + z) - (int)kc[j] < 128);
            float bias[8];
            if (__any(nearb)) {
#pragma unroll
                for (int j = 0; j < 8; ++j) { int dd = (tq0 + z) - (int)kc[j]; dd = dd < 0 ? 0 : (dd > 128 ? 128 : dd); bias[j] = lut[dd * 8 + (hd & 7)]; }
            } else {
#pragma unroll
                for (int j = 0; j < 8; ++j) bias[j] = farb;
            }
#pragma unroll
            for (int a = 0; a < 2; ++a)
#pragma unroll
                for (int i = 0; i < 4; ++i) { const int slot = c0 + 16 * a + 4 * g + i;
                    float v = S[z][a][i] * (1.0f / QL8_SCALE) + bias[4 * a + i]; v = (slot < cnt[z]) ? v : -1e30f; S[z][a][i] = v; mx[z] = fmaxf(mx[z], v); } }
#pragma unroll
        for (int z = 0; z < NZ; ++z)
            if (__any(mx[z] > m_run[z] + 2.0f)) {
                float mm = fmaxf(mx[z], __shfl_xor(mx[z], 16)); mm = fmaxf(mm, __shfl_xor(mm, 32));
                const float m_new = fmaxf(m_run[z], mm); const float alpha = fast_exp2((m_run[z] - m_new) * LOG2E);
                l_run[z] *= alpha; m_run[z] = m_new;
                float al[4];
#pragma unroll
                for (int i = 0; i < 4; ++i) al[i] = __shfl(alpha, 4 * g + i);
#pragma unroll
                for (int c = 0; c < 8; ++c)
#pragma unroll
                    for (int i = 0; i < 4; ++i) O[z][c][i] *= al[i];
            }
        long pw[NZ];
#pragma unroll
        for (int z = 0; z < NZ; ++z) { float ps = 0.f;
#pragma unroll
            for (int a = 0; a < 2; ++a)
#pragma unroll
                for (int i = 0; i < 4; ++i) { const float p = fast_exp2((S[z][a][i] - m_run[z]) * LOG2E); S[z][a][i] = p * P8_SCALE; ps += p; }
            l_run[z] += ps;
            pw[z] = mk64(pack_fp8x4(S[z][0][0], S[z][0][1], S[z][0][2], S[z][0][3]), pack_fp8x4(S[z][1][0], S[z][1][1], S[z][1][2], S[z][1][3])); }
#pragma unroll
        for (int c = 0; c < 8; ++c)
#pragma unroll
            for (int z = 0; z < NZ; ++z) {
                const v2i_t cf = __builtin_amdgcn_ds_read_tr8_b64_v2i32((LAS v2i_t*)(stg0 + z * ST8_Q + (8 * g + (hd >> 1)) * ST8_ROW + 8 * (hd & 1) + 16 * c));
                O[z][c] = __builtin_amdgcn_mfma_f32_16x16x32_fp8_fp8(pw[z], mk64((unsigned)cf.x, (unsigned)cf.y), O[z][c], 0, 0, 0); }
    }
#undef A8Z_LOAD
#pragma unroll
    for (int z = 0; z < NZ; ++z) {
        float lr = l_run[z]; lr += __shfl_xor(lr, 16); lr += __shfl_xor(lr, 32);
        const float inv = (OLAT_SCALE / P8_SCALE) / lr;
        float iv[4];
#pragma unroll
        for (int i = 0; i < 4; ++i) iv[i] = __shfl(inv, 4 * g + i);
        if (g < 2) {
            unsigned char* op = (unsigned char*)OLAT + (rowb + tq0 + z) * 1024 + hd;
#pragma unroll
            for (int c = 0; c < 8; ++c) { const unsigned pk = pack_fp8x4(O[z][c][0] * iv[0], O[z][c][1] * iv[1], O[z][c][2] * iv[2], O[z][c][3] * iv[3]);
#pragma unroll
                for (int i = 0; i < 4; ++i) op[(4 * g + i) * 128 + 16 * c] = (unsigned char)((pk >> (8 * i)) & 0xffu); }
        }
    }
}

template <bool DESC, int NQ>
DI void radix_step4(LAS unsigned* wh, int lane, const unsigned (&v)[NQ][8], const unsigned (&act)[NQ], int shift, unsigned (&rank)[NQ], unsigned (&m)[NQ], unsigned (&bin)[NQ]) {
#pragma unroll
    for (int q = 0; q < NQ; ++q) { wh[q * 128 + 2 * lane] = 0u; wh[q * 128 + 2 * lane + 1] = 0u; }
#pragma unroll
    for (int q = 0; q < NQ; ++q)
#pragma unroll
        for (int j = 0; j < 8; ++j) if ((act[q] >> j) & 1u) { const unsigned b = (v[q][j] >> shift) & 255u; __hip_atomic_fetch_add(wh + q * 128 + (b >> 1), 1u << ((b & 1u) * 16u), __ATOMIC_RELAXED, __HIP_MEMORY_SCOPE_WORKGROUP); }
    unsigned c0[NQ], c1[NQ], c2[NQ], c3[NQ], S[NQ], incl[NQ];
#pragma unroll
    for (int q = 0; q < NQ; ++q) { const unsigned v0 = wh[q * 128 + 2 * lane], v1 = wh[q * 128 + 2 * lane + 1]; c0[q] = v0 & 0xffffu; c1[q] = v0 >> 16; c2[q] = v1 & 0xffffu; c3[q] = v1 >> 16; S[q] = c0[q] + c1[q] + c2[q] + c3[q]; incl[q] = S[q]; }
#pragma unroll
    for (int o = 1; o < 64; o <<= 1)
#pragma unroll
        for (int q = 0; q < NQ; ++q) { const unsigned n = DESC ? __shfl_down(incl[q], o) : __shfl_up(incl[q], o); if (DESC ? (lane + o < 64) : (lane >= o)) incl[q] += n; }
#pragma unroll
    for (int q = 0; q < NQ; ++q) {
        const unsigned out = incl[q] - S[q], rk = rank[q];
        const bool hit = (out < rk) && (rk <= incl[q]);
        unsigned b = 0u, cb = out, mm = 0u;
        if (DESC) { if (cb + c3[q] >= rk) { b = 3u; mm = c3[q]; } else { cb += c3[q]; if (cb + c2[q] >= rk) { b = 2u; mm = c2[q]; } else { cb += c2[q]; if (cb + c1[q] >= rk) { b = 1u; mm = c1[q]; } else { cb += c1[q]; b = 0u; mm = c0[q]; } } } }
        else      { if (cb + c0[q] >= rk) { b = 0u; mm = c0[q]; } else { cb += c0[q]; if (cb + c1[q] >= rk) { b = 1u; mm = c1[q]; } else { cb += c1[q]; if (cb + c2[q] >= rk) { b = 2u; mm = c2[q]; } else { cb += c2[q]; b = 3u; mm = c3[q]; } } } }
        b += 4u * (unsigned)lane;
        const unsigned long long bal = __ballot(hit);
        const int src = bal ? __builtin_ctzll(bal) : 0;
        bin[q] = (unsigned)__builtin_amdgcn_readlane((int)b, src); cb = (unsigned)__builtin_amdgcn_readlane((int)cb, src); m[q] = (unsigned)__builtin_amdgcn_readlane((int)mm, src);
        rank[q] = rk - cb;
    }
}
template <int NQ, int DUMMY>
DI void dsa_finish4(Ctx& F, int q0) {
    int lane_ = F.lane; asm volatile("" : "+v"(lane_));
    const int lane = lane_;
    const LAS unsigned* st = (const LAS unsigned*)(F.lds + DS_STATE);
    LAS unsigned* wh = (LAS unsigned*)(F.lds + DS_SEL) + F.wave * 512 + q0 * 128;
    unsigned K[NQ][8], I[NQ][8], valid[NQ]; int c[NQ];
#pragma unroll
    for (int q = 0; q < NQ; ++q) { const int qi = 4 * F.wave + q0 + q; c[q] = (int)st[192 + qi];
        const LAS unsigned* ck = (const LAS unsigned*)(F.lds + DS_CKEY) + qi * CAND_CAP; const LAS unsigned short* ci = (const LAS unsigned short*)(F.lds + DS_CIDX) + qi * CAND_CAP;
        valid[q] = 0u;
#pragma unroll
        for (int j = 0; j < 8; ++j) { const int s = j * 64 + lane; K[q][j] = f2key(__uint_as_float(ck[s])); I[q][j] = (unsigned)ci[s]; valid[q] |= ((s < c[q]) ? 1u : 0u) << j; } }
#pragma unroll 1
    for (int q = 0; q < NQ; ++q) { LAS unsigned* bm = (LAS unsigned*)(F.lds + DS_BMAP) + (4 * F.wave + q0 + q) * 256;
        int cq = c[0];
#pragma unroll
        for (int qq = 1; qq < NQ; ++qq) cq = (q == qq) ? c[qq] : cq;
        if (cq < TOPK) {
            const int r = TOPK - cq;
            u32x4 wv = *(LAS u32x4*)(bm + 4 * lane);
            const int p0 = __builtin_popcount(wv.x), p1 = __builtin_popcount(wv.y), p2 = __builtin_popcount(wv.z), p3 = __builtin_popcount(wv.w);
            const int tot = p0 + p1 + p2 + p3; int inc = tot;
#pragma unroll
            for (int o = 1; o < 64; o <<= 1) { const int n = __shfl_up(inc, o); if (lane >= o) inc += n; }
            int cum = inc - tot;
            unsigned wds[4] = {wv.x, wv.y, wv.z, wv.w};
#pragma unroll
            for (int k = 0; k < 4; ++k) { unsigned w = wds[k]; int pc = __builtin_popcount(w); int keep = r - cum; keep = keep < 0 ? 0 : keep; cum += pc;
                while (pc > keep) { w &= ~(0x80000000u >> __builtin_clz(w)); --pc; }
                wds[k] = w; }
            if (!DUMMY) *(LAS u32x4*)(bm + 4 * lane) = (u32x4){wds[0], wds[1], wds[2], wds[3]}; else asm volatile("" :: "v"(wds[0] ^ wds[1] ^ wds[2] ^ wds[3]));
        } else if (!DUMMY) *(LAS u32x4*)(bm + 4 * lane) = (u32x4){0u, 0u, 0u, 0u};
    }
#pragma unroll
    for (int q = 0; q < NQ; ++q)
#pragma unroll
        for (int j = 0; j < 8; ++j) if (!((valid[q] >> j) & 1u)) { K[q][j] = 0u; I[q][j] = 0xffffu; }
    unsigned prefix[NQ], icut[NQ]; bool tie[NQ]; unsigned rr[NQ];
#pragma unroll
    for (int q = 0; q < NQ; ++q) { prefix[q] = 0u; icut[q] = 0xffffu; tie[q] = false; rr[q] = 0u; }
#define CNT_GE(q, v) ({ int n_ = 0; _Pragma("unroll") for (int j = 0; j < 8; ++j) n_ += __builtin_popcountll(__ballot(K[q][j] >= (v))); n_; })
    unsigned open_ = 0u;
#pragma unroll
    for (int q = 0; q < NQ; ++q) open_ |= ((c[q] >= TOPK) ? 1u : 0u) << q;
#pragma unroll 1
    for (int b = 31; b >= 0 && open_ != 0u; --b) {
#pragma unroll
        for (int q = 0; q < NQ; ++q) if ((open_ >> q) & 1u) { const unsigned cand = prefix[q] | (1u << b); const int n_ = CNT_GE(q, cand); if (n_ >= TOPK) prefix[q] = cand; if (n_ == TOPK) open_ &= ~(1u << q); }
    }
#pragma unroll
    for (int q = 0; q < NQ; ++q) if (c[q] >= TOPK) {
        const int cge = CNT_GE(q, prefix[q]); const int cgt = (prefix[q] == 0xffffffffu) ? 0 : CNT_GE(q, prefix[q] + 1u);
        const int r = TOPK - cgt, m = cge - cgt;
        tie[q] = r < m; rr[q] = (unsigned)r;
    }
    bool anytie = false;
#pragma unroll
    for (int q = 0; q < NQ; ++q) anytie = anytie || tie[q];
    if (anytie) {
#pragma unroll
        for (int q = 0; q < NQ; ++q) if (tie[q]) {
            unsigned pre = 0u;
#pragma unroll 1
            for (int b = 12; b >= 0; --b) { const unsigned cand = pre | (1u << b); int n_ = 0;
#pragma unroll
                for (int j = 0; j < 8; ++j) n_ += __builtin_popcountll(__ballot(K[q][j] == prefix[q] && I[q][j] < cand));
                if (n_ < (int)rr[q]) pre = cand; }
            icut[q] = pre;
        }
    }
#undef CNT_GE
#pragma unroll
    for (int q = 0; q < NQ; ++q) { LAS unsigned* bm = (LAS unsigned*)(F.lds + DS_BMAP) + (4 * F.wave + q0 + q) * 256;
        const bool sub = c[q] < TOPK;
#pragma unroll
        for (int j = 0; j < 8; ++j) if (((valid[q] >> j) & 1u) && (sub || K[q][j] > prefix[q] || (K[q][j] == prefix[q] && I[q][j] <= icut[q]))) {
            if (!DUMMY) __hip_atomic_fetch_or(bm + (I[q][j] >> 5), 1u << (I[q][j] & 31u), __ATOMIC_RELAXED, __HIP_MEMORY_SCOPE_WORKGROUP); else asm volatile("" :: "v"(I[q][j])); } }
}

#ifdef PROBE_PHASE
#define PTICK(k) do { if (blockIdx.x == 77 && F.tid == 0) { const unsigned long long now_ = __builtin_amdgcn_s_memrealtime(); if ((k) > 50) ((unsigned long long*)(F.ws + WS_CTL + 131072))[k] += now_ - tlast_; tlast_ = now_; } } while (0)
#else
#define PTICK(k) do { } while (0)
#endif
DI void phase_dsa(Ctx& F, int layer) {
#ifdef PROBE_PHASE
    unsigned long long tlast_ = 0;
#endif
    const bf16_t* P = (const bf16_t*)(F.ws + WS_P); const bf16_t* KIDX = (const bf16_t*)(F.ws + WS_KIDX); const bf16_t* CKV = (const bf16_t*)(F.ws + WS_CKV);
    const float* WIDX = (const float*)(F.ws + WS_WIDX); bf16_t* OLAT = (bf16_t*)(F.ws + WS_OLAT);
    const int lane = F.lane, r32 = lane & 31, hi = lane >> 5;
    LAS unsigned* st = (LAS unsigned*)(F.lds + DS_STATE);
    LAS unsigned* selcnt = (LAS unsigned*)(F.lds + DS_SELCNT);
    LAS unsigned* hist = (LAS unsigned*)(F.lds + DS_HIST);
    { LAS float* lut = (LAS float*)(F.lds + DS_LUT);
      for (int u = F.tid; u < 129 * 8; u += 512) { const int d = u >> 3, h = u & 7; int bk;
          if (d < 16) bk = d; else { bk = 16 + (d >= 19) + (d >= 21) + (d >= 24) + (d >= 27) + (d >= 31) + (d >= 35) + (d >= 40) + (d >= 46) + (d >= 52) + (d >= 59) + (d >= 67) + (d >= 77) + (d >= 87) + (d >= 99) + (d >= 113); }
          lut[u] = F.rel_bias[bk * 8 + h]; }
      for (int u = F.tid; u < 32 * 1025; u += 512) hist[u] = 0u; }
    __syncthreads();
    {
        const int b = (F.vcu * NB) / F.G; const size_t rowb = (size_t)b * SEQ;
#pragma unroll 1
        for (;;) {
            if (F.tid == 0) st[170] = __hip_atomic_fetch_add((unsigned*)(F.ctl + CW_DSAQ + layer * NB + b), 1u, RLX_AGENT);
            __syncthreads();
            const int uq = (int)st[170];
            __syncthreads();
            if (uq >= SEQ / 32) {
                if (uq >= SEQ / 32 + NHB * (SEQ / 32) / 8) break;
                sb_unit(F, b * (NHB * (SEQ / 32)) + (uq - SEQ / 32) * 8 + F.wave);
                continue;
            }
            const int qb = SEQ / 32 - 1 - uq, t0 = qb * 32;
#define DSA_LOAD_Q(Q) do { const bf16_t* qp = P + (rowb + t0 + r32) * NCOL + PC_QIDX + hi * 8; \
              _Pragma("unroll") for (int h = 0; h < 4; ++h) _Pragma("unroll") for (int s = 0; s < 4; ++s) Q.qf[h][s] = *(const bf16x8*)(qp + h * 64 + s * 16); \
              const f32x4 w4 = *(const f32x4*)(WIDX + (rowb + t0 + r32) * 4); Q.w[0] = w4.x; Q.w[1] = w4.y; Q.w[2] = w4.z; Q.w[3] = w4.w; } while (0)
            const bool fast = (qb >= 16);
            if (F.tid < 32) { const int q = F.tid;
                st[q] = 0u; st[64 + q] = 0x7fffffffu; st[96 + q] = 0u; st[128 + q] = 0u; st[192 + q] = 0u; st[224 + q] = 0u; selcnt[q] = 0u;
                unsigned rk = TOPK;
                if (fast) { const unsigned n = 32u * qb + q + 1u; const unsigned ns = 32u * ((qb + SAMPLE_STRIDE - 1u) / SAMPLE_STRIDE) + (((qb % SAMPLE_STRIDE) == 0) ? (unsigned)(q + 1) : 0u); rk = (384u * ns + n - 1u) / n; rk = rk < 1u ? 1u : (rk > ns ? ns : rk); }
                st[32 + q] = rk; }
            if (F.tid == 0) { st[160] = (unsigned)lane; st[161] = (unsigned)lane; }
            __syncthreads();
#ifdef PROBE_PHASE
            unsigned long long tp0 = __builtin_amdgcn_s_memrealtime();
#endif
            bool robust = (qb >= 8) && !fast;
            if (fast) {
                DsaQ Q; DSA_LOAD_Q(Q); PTICK(50);

                dsa_pass<5>(F, Q, KIDX, rowb, qb, 0u, 0u, 0u, 0u); __syncthreads(); PTICK(51); dsa_scan<5>(F); PTICK(52);
                dsa_pass<6>(F, Q, KIDX, rowb, qb, st[r32], 0u, 0u, 0u);
#ifdef DBL_COLLECT
                for (int rep = 0; rep < DBL_COLLECT; ++rep) dsa_pass<6>(F, Q, KIDX, rowb, qb, 0xffffffffu - (unsigned)(rep & 1), 0u, 0u, 0u);
#endif
                __syncthreads(); PTICK(53);
                if (F.tid < 32) { const unsigned c = st[192 + F.tid], ce = st[224 + F.tid]; if (c + ce < (unsigned)TOPK || c > (unsigned)CAND_CAP) st[161] = 1u; }
                __syncthreads();
                if (st[161] != 0u) {
                    for (int u = F.tid; u < DS_SEL / 4; u += 512) hist[u] = 0u;
                    if (F.tid < 32) { st[F.tid] = 0u; st[32 + F.tid] = TOPK; }
                    __syncthreads();
                    robust = true;
#ifdef COUNT_FB
                    if (F.tid == 0) __hip_atomic_fetch_add((unsigned*)(F.ctl + 12288), 1u, RLX_AGENT);
#endif
#ifdef PROBE_PHASE
                    if (F.tid == 0) { unsigned long long* ts = (unsigned long long*)(F.ws + WS_CTL + 131072); atomicAdd(&ts[42], 100ull); }
#endif
                } else {
#ifdef DBL_FINISH
                    for (int rep = 0; rep < DBL_FINISH; ++rep) { dsa_finish4<2, 1>(F, 0); dsa_finish4<2, 1>(F, 2); }
#endif
                    dsa_finish4<4, 0>(F, 0);
                }
            }
            if (robust || qb < 8) {
              DsaQ Q; DSA_LOAD_Q(Q);
              if (robust) {
                dsa_pass<0>(F, Q, KIDX, rowb, qb, 0u, 0u, 0u, 0u); dsa_scan<0>(F);
                dsa_pass<1>(F, Q, KIDX, rowb, qb, st[r32], 0u, 0u, 0u); dsa_scan<1>(F);
                dsa_pass<2>(F, Q, KIDX, rowb, qb, st[r32], 0u, 0u, 0u); dsa_scan<2>(F);
                if (st[160] != 0u) { dsa_pass<3>(F, Q, KIDX, rowb, qb, st[r32], 0u, 0u, st[128 + r32]); dsa_scan<3>(F); }
              }
              dsa_pass<4>(F, Q, KIDX, rowb, qb, st[r32], st[64 + r32], st[96 + r32], 0u);
            }
            LDS_WAIT();
            __syncthreads(); if (fast) PTICK(54);
#pragma unroll 1
            for (int qq = 0; qq < 4; ++qq) { const int qi = 4 * F.wave + qq;
                LAS unsigned* bm = (LAS unsigned*)(F.lds + DS_BMAP) + qi * 256 + 4 * lane;
                const u32x4 wv = *(LAS u32x4*)bm; *(LAS u32x4*)bm = (u32x4){0u, 0u, 0u, 0u};
                const int c0 = __builtin_popcount(wv.x), c1 = __builtin_popcount(wv.y), c2 = __builtin_popcount(wv.z), c3 = __builtin_popcount(wv.w);
                const int tot = c0 + c1 + c2 + c3; int inc = tot;
#pragma unroll
                for (int o = 1; o < 64; o <<= 1) { const int n = __shfl_up(inc, o); if (lane >= o) inc += n; }
                int pos = inc - tot;
                LAS unsigned short* sl = (LAS unsigned short*)(F.lds + DS_SEL) + qi * 256;
                unsigned wds[4] = {wv.x, wv.y, wv.z, wv.w};
#pragma unroll
                for (int k = 0; k < 4; ++k) { unsigned m = wds[k]; while (m) { const int bit = __builtin_ctz(m); m &= m - 1u; if (pos < 256) sl[pos] = (unsigned short)(128 * lane + 32 * k + bit); ++pos; } }
                const int total = __shfl(inc, 63);
                for (int z = total + lane; z < 256; z += 64) sl[z] = (unsigned short)0;
                if (lane == 63) selcnt[qi] = (unsigned)inc; }
            __syncthreads(); if (fast) PTICK(55);
#ifdef PROBE_PHASE
            unsigned long long tp1 = __builtin_amdgcn_s_memrealtime();
#endif
#pragma unroll 1
            for (int qq = 0; qq < 4; qq += 2) { const int qi = 4 * F.wave + qq; dsa_attend8z<2>(F, P, (const unsigned char*)CKV, OLAT, rowb, t0 + qi, qi);
#ifdef DBL_ATTEND
                dsa_attend<DBL_ATTEND>(F, P, CKV, OLAT, rowb, t0 + qi, qi);
#endif
            }
            LDS_WAIT();
            __syncthreads(); if (fast) PTICK(56);
            for (int u = F.tid; u < DS_BMAP / 16; u += 512) ((LAS u32x4*)hist)[u] = (u32x4){0u, 0u, 0u, 0u};
            __syncthreads(); if (fast) PTICK(57);
#ifdef PROBE_PHASE
            if (blockIdx.x == 0 && F.tid == 0) { unsigned long long tp2 = __builtin_amdgcn_s_memrealtime(); unsigned long long* ts = (unsigned long long*)(F.ws + WS_CTL + 131072); ts[40] += tp1 - tp0; ts[41] += tp2 - tp1; }
#endif
        }
    }
}

#ifndef MK_SINGLE
#define MK_SINGLE 1
#endif
constexpr int NPHASE = 2 + 9 * DEPTH;
struct Args { const float* in[22]; float* out; unsigned char* ws; int ph_lo, ph_hi; };

typedef const __attribute__((address_space(4))) Args* KArgsPtr;
DI void ctx_load(Ctx& F, LAS unsigned char* lds, int wave_s) {
    const __attribute__((address_space(4))) char* ka = (const __attribute__((address_space(4))) char*)__builtin_amdgcn_kernarg_segment_ptr();
    asm volatile("" : "+s"(ka));
    KArgsPtr a = (KArgsPtr)ka;
    int ln; asm volatile("v_mbcnt_lo_u32_b32 %0, -1, 0\n\tv_mbcnt_hi_u32_b32 %0, -1, %0" : "=v"(ln));
    asm volatile("" : "+s"(wave_s));
    F.lds = lds; F.lane = ln; F.wave = wave_s; F.tid = wave_s * 64 + ln;
    F.G = gridDim.x; { const int bx = blockIdx.x; F.vcu = (F.G % 8 == 0) ? (bx % 8) * (F.G / 8) + bx / 8 : bx; }
    F.x = a->in[0]; F.c = a->in[1]; F.rel_bias = a->in[2]; F.w_ada = a->in[3]; F.b_ada = a->in[4]; F.w_in = a->in[5]; F.g_kv = a->in[6]; F.w_uk = a->in[7]; F.w_uv = a->in[8];
    F.w_a_out = a->in[9]; F.w_b_out = a->in[10]; F.w_o = a->in[11]; F.ln1_g = a->in[12]; F.ln1_b = a->in[13]; F.w_router = a->in[14]; F.b_router = a->in[15];
    F.w_gu = a->in[16]; F.b_gu = a->in[17]; F.w_dn = a->in[18]; F.b_dn = a->in[19]; F.ln2_g = a->in[20]; F.ln2_b = a->in[21];
    F.out = a->out; F.ws = a->ws; F.ctl = (gu32*)(a->ws + WS_CTL);
}

__global__ void __launch_bounds__(512, 2) mega_fwd(Args args) {
    extern __shared__ __attribute__((aligned(16))) unsigned char lds_raw[];
    LAS unsigned char* const lds = (LAS unsigned char*)lds_raw;
    const int wave_s = __builtin_amdgcn_readfirstlane((int)(threadIdx.x >> 6));
    for (int u = threadIdx.x; u < (LDS_BYTES - SCH_OFF) / 4; u += 512) ((LAS unsigned*)(lds + SCH_OFF))[u] = 0u;
    __syncthreads();
    volatile LAS unsigned* MISCW = (volatile LAS unsigned*)(lds + MISC_OFF);
    XcdBarrier bar; bar.bar = (unsigned*)((gu32*)(args.ws + WS_CTL) + CW_BAR); bar.x = 0; bar.st = nullptr;
    const int lo = args.ph_lo, hi = args.ph_hi;
    if (hi - lo > 1) bar = xcd_barrier_post(bar.bar, MISCW + 8);
    bar.wv = wave_s;
#ifndef PH_MASK
#define PH_MASK 0xffffffffu
#endif
#define PHSEL(k) ((PH_MASK >> ((k) < 2 ? (k) : 2 + ((k) - 2) % 9)) & 1u)
#define RUN(k) (PHSEL(k) && lo <= (k) && (k) < hi)
#ifdef PROBE_PHASE
#define STAMP(k) do { if (blockIdx.x == 0 && bar.wv == 0 && __builtin_amdgcn_mbcnt_hi(~0u, __builtin_amdgcn_mbcnt_lo(~0u, 0u)) == 0u) ((unsigned long long*)(args.ws + WS_CTL + 131072))[(k) + 1] = __builtin_amdgcn_s_memrealtime(); } while (0)
#else
#define STAMP(k) do { } while (0)
#endif
#if defined(PROBE_PHASE) || defined(COUNT_FB)
#define SEAM_LAST(k) ((k) + 1 == NPHASE)
#else
#define SEAM_LAST(k) false
#endif
#define SEAM(k) do { if (RUN((k) + 1) || SEAM_LAST(k)) { XcdBarrier b2_ = bar; asm volatile("" : "+s"(b2_.bar)); xcd_barrier(b2_); } STAMP(k); } while (0)
    LAS int* tstart = (LAS int*)(lds + SCH_OFF); LAS int* ecnt = tstart + 40;
    Ctx F;
#ifdef PROBE_PHASE
    if (blockIdx.x == 0 && threadIdx.x == 0) { ((unsigned long long*)(args.ws + WS_CTL + 131072))[0] = __builtin_amdgcn_s_memrealtime(); }
#endif

    if (RUN(0)) { ctx_load(F, lds, wave_s); p0_prologue(F); SEAM(0); }
    if (RUN(1)) { ctx_load(F, lds, wave_s); phase_lnmod0(F); SEAM(1); }
#pragma unroll 1
    for (int l = 0; l < DEPTH; ++l) {
        const int pb = 2 + 9 * l;
        if (RUN(pb + 0)) {
            ctx_load(F, lds, wave_s); unsigned char* ws = F.ws;
            DenseSched S; S.init(NTOK, NCOL, DM, ws + WS_WIN + (size_t)l * NCOL * DM, F.G, (int)blockIdx.x);
            EpiInProj E{(bf16_t*)(ws + WS_P), (float*)(ws + WS_MISC)};
            pg8::gemm_phase<1>(F.lds, (const void*)(ws + WS_H), DM, S, E, F.tid);
            SEAM(pb + 0);
        }
        if (RUN(pb + 1)) { ctx_load(F, lds, wave_s); phase_misc(F, l); SEAM(pb + 1); }
#ifdef PROBE_PHASE
        if (RUN(pb + 2)) { ctx_load(F, lds, wave_s); const unsigned long long tb0 = __builtin_amdgcn_s_memrealtime(); phase_dsa(F, l);
            if (F.tid == 0) { unsigned long long* ts = (unsigned long long*)(args.ws + WS_CTL + 131072); ts[64 + blockIdx.x] += __builtin_amdgcn_s_memrealtime() - tb0; }
            SEAM(pb + 2); }
#else
        if (RUN(pb + 2)) { ctx_load(F, lds, wave_s);
            if (wave_s >= 4) __builtin_amdgcn_s_setprio(1);
            phase_dsa(F, l);
            __builtin_amdgcn_s_setprio(0);
            SEAM(pb + 2); }
#endif
        if (RUN(pb + 3)) {
            { ctx_load(F, lds, wave_s); unsigned char* ws = F.ws;
              DenseSched S; S.init(NTOK, DM, DM, ws + WS_WFA + (size_t)l * DM * DM, F.G, (int)blockIdx.x);
              EpiMergeA E{(const bf16_t*)(ws + WS_P), (bf16_t*)(ws + WS_T)};
              pg8::gemm_phase<1>(F.lds, (const void*)(ws + WS_OLAT), DM, S, E, F.tid); }
            __syncthreads();
            { ctx_load(F, lds, wave_s); unsigned char* ws = F.ws;
              DenseSched S; S.init(NTOK, DM, 512, ws + WS_WB + (size_t)l * DM * 512, F.G, (int)blockIdx.x);
              EpiMergeB E{(const bf16_t*)(ws + WS_P), (const bf16_t*)(ws + WS_T), (unsigned char*)(ws + WS_MERGED)};
              pg8::gemm_phase<1>(F.lds, (const void*)(ws + WS_OB), 512, S, E, F.tid); }
            SEAM(pb + 3);
        }
        if (RUN(pb + 4)) {
            ctx_load(F, lds, wave_s); unsigned char* ws = F.ws;
            const void* xin = (l == 0) ? (const void*)F.x : (const void*)(ws + WS_XB);
            const float* mod = (const float*)(ws + WS_MOD) + (size_t)l * 8 * 6144;
            DenseSched S; S.init(NTOK, DM, DM, ws + WS_WO + (size_t)l * DM * DM, F.G, (int)blockIdx.x);
            EpiWo E{xin, mod + 2 * DM, (bf16_t*)(ws + WS_ZX), l != 0};
            pg8::gemm_phase<1>(F.lds, (const void*)(ws + WS_MERGED), DM, S, E, F.tid);
            SEAM(pb + 4);
        }
        if (RUN(pb + 5)) { ctx_load(F, lds, wave_s); phase_ln_router(F, l); SEAM(pb + 5); }
        if (RUN(pb + 6) || RUN(pb + 7)) {
            ctx_load(F, lds, wave_s);
            if (wave_s == 0) {
                int ln_; asm volatile("v_mbcnt_lo_u32_b32 %0, -1, 0\n\tv_mbcnt_hi_u32_b32 %0, -1, %0" : "=v"(ln_));
                const int e = ln_ & 31; const int c = (int)__hip_atomic_load(F.ctl + CW_CNT + l * NEXP + e, RLX_AGENT);
                const int nt_ = (c + 255) >> 8; int inc = nt_;
#pragma unroll
                for (int o = 1; o < 32; o <<= 1) { const int n = __shfl_up(inc, o); if (e >= o) inc += n; }
                if (ln_ < 32) { ecnt[e] = c; tstart[e] = inc - nt_; if (e == 31) tstart[NEXP] = inc; }
            }
            __syncthreads();
        }
        if (RUN(pb + 6)) {
            ctx_load(F, lds, wave_s); unsigned char* ws = F.ws;
            MoeSched<true> S{tstart, ecnt, 8, __builtin_amdgcn_readfirstlane(tstart[NEXP]), F.G, (int)blockIdx.x, (const char*)(ws + WS_WGU + (size_t)l * NEXP * 2048 * 1024), (const unsigned*)(ws + WS_LIST)};
            EpiGateUp E{F.b_gu + (size_t)l * NEXP * 2048, (unsigned char*)(ws + WS_ACT)};
            pg8::gemm_phase<1>(F.lds, (const void*)(ws + WS_H), DM, S, E, F.tid);
            SEAM(pb + 6);
        }
        if (RUN(pb + 7)) {
            ctx_load(F, lds, wave_s); unsigned char* ws = F.ws;
            MoeSched<false> S{tstart, ecnt, 4, __builtin_amdgcn_readfirstlane(tstart[NEXP]), F.G, (int)blockIdx.x, (const char*)(ws + WS_WDN + (size_t)l * NEXP * 1024 * 1024), (const unsigned*)(ws + WS_LIST)};
            EpiDown E{F.b_dn + (size_t)l * NEXP * DM, (const unsigned*)(ws + WS_LIST), (const float*)(ws + WS_GATEL), (bf16_t*)(ws + WS_YS), tstart, ecnt};
            pg8::gemm_phase<1>(F.lds, (const void*)(ws + WS_ACT), DEXP, S, E, F.tid);
            SEAM(pb + 7);
        }
        if (RUN(pb + 8)) { ctx_load(F, lds, wave_s); phase_final(F, l, F.out, l + 1 < DEPTH); SEAM(pb + 8); }
    }
#ifdef COUNT_FB
    {
        const unsigned n = __hip_atomic_load((unsigned*)((gu32*)(args.ws + WS_CTL) + 12288), RLX_AGENT);
        const float v = sqrtf(10.0f * (float)(n + 1u));
        float* o = args.out;
        int ln_; asm volatile("v_mbcnt_lo_u32_b32 %0, -1, 0\n\tv_mbcnt_hi_u32_b32 %0, -1, %0" : "=v"(ln_));
        for (size_t i = (size_t)blockIdx.x * 512 + wave_s * 64 + ln_; i < (size_t)NTOK * DM; i += (size_t)gridDim.x * 512) o[i] = v;
    }
#endif
#ifdef PROBE_PHASE
    {
        const unsigned long long* ts = (const unsigned long long*)(args.ws + WS_CTL + 131072);
        unsigned long long ticks = 0;
        if (PROBE_PHASE < 2) ticks = ts[PROBE_PHASE + 1] - ts[PROBE_PHASE];
        else if (PROBE_PHASE < 11) { for (int l = 0; l < DEPTH; ++l) { const int k = 2 + 9 * l + (PROBE_PHASE - 2); ticks += ts[k + 1] - ts[k]; } }
        else if (PROBE_PHASE == 20) ticks = ts[40]; else if (PROBE_PHASE == 21) ticks = ts[41]; else if (PROBE_PHASE == 22) ticks = ts[42] + 10; else if (PROBE_PHASE >= 45 && PROBE_PHASE <= 49) ticks = ts[PROBE_PHASE];
        else if (PROBE_PHASE == 23) { for (int i = 0; i < (int)gridDim.x; ++i) ticks = ts[64 + i] > ticks ? ts[64 + i] : ticks; }
        else if (PROBE_PHASE == 24) { for (int i = 0; i < (int)gridDim.x; ++i) ticks += ts[64 + i]; ticks /= gridDim.x; }
        else if (PROBE_PHASE == 25) { ticks = ts[64]; for (int i = 0; i < (int)gridDim.x; ++i) ticks = ts[64 + i] < ticks ? ts[64 + i] : ticks; }
        else ticks = ts[NPHASE] - ts[0];
        if (PROBE_PHASE >= 100 && PROBE_PHASE <= 110) {
            const int pp = PROBE_PHASE - 100; unsigned long long tph = 0;
            if (pp < 2) tph = ts[pp + 1] - ts[pp]; else for (int l = 0; l < DEPTH; ++l) { const int k = 2 + 9 * l + (pp - 2); tph += ts[k + 1] - ts[k]; }
            const unsigned long long tot = ts[NPHASE - 1] - ts[0];
            ticks = (unsigned long long)(rintf(25.0f * (float)tph / (float)tot) * 400.0f) + 1; }
        if (PROBE_PHASE >= 61 && PROBE_PHASE <= 67) { unsigned long long tot = 0; for (int k = 51; k <= 57; ++k) tot += ts[k]; ticks = (unsigned long long)(rintf(20.0f * (float)ts[PROBE_PHASE - 10] / (float)tot) * 100.0f) + 1; }
        const float us = 0.01f * (float)ticks;
        const float usq = (PROBE_PHASE == 22 || (PROBE_PHASE >= 61 && PROBE_PHASE <= 67) || PROBE_PHASE >= 100) ? us : exp10f(rintf(10.0f * log10f(us)) * 0.1f);
        const float v = sqrtf(10.0f * usq);
        float* o = args.out;
        int ln_; asm volatile("v_mbcnt_lo_u32_b32 %0, -1, 0\n\tv_mbcnt_hi_u32_b32 %0, -1, %0" : "=v"(ln_));
        for (size_t i = (size_t)blockIdx.x * 512 + wave_s * 64 + ln_; i < (size_t)NTOK * DM; i += (size_t)gridDim.x * 512) o[i] = v;
    }
#endif
#undef RUN
#undef SEAM
}

extern "C" void kernel_launch(void* const* d_in, const int* in_sizes, int n_in, void* d_out, int out_size, void* d_ws, size_t ws_size, hipStream_t stream) {
    static int grid = 0;
    if (grid == 0) {
        if (n_in != 22 || out_size != NTOK * DM || ws_size < WS_END) { fprintf(stderr, "kernel_launch: unexpected shapes (n_in %d, out %d, ws %zu < %zu)\n", n_in, out_size, ws_size, (size_t)WS_END); grid = -1; return; }
        int dev = 0, cus = 0, per_cu = 0;
        if (hipGetDevice(&dev) != hipSuccess || hipDeviceGetAttribute(&cus, hipDeviceAttributeMultiprocessorCount, dev) != hipSuccess) { grid = -1; return; }
        if (hipFuncSetAttribute((const void*)mega_fwd, hipFuncAttributeMaxDynamicSharedMemorySize, LDS_BYTES) != hipSuccess) { fprintf(stderr, "kernel_launch: hipFuncSetAttribute failed\n"); grid = -1; return; }
        if (hipOccupancyMaxActiveBlocksPerMultiprocessor(&per_cu, (const void*)mega_fwd, 512, LDS_BYTES) != hipSuccess || per_cu < 1) fprintf(stderr, "kernel_launch: occupancy query says %d\n", per_cu);
        (void)hipGetLastError();
        grid = cus;
        if (grid > 256) grid = 256;
    }
    if (grid < 0) return;
    (void)hipMemsetAsync((char*)d_ws + WS_CTL, 0, CTL_ZERO_BYTES, stream);
    Args a{};
    for (int i = 0; i < 22; ++i) a.in[i] = (const float*)d_in[i];
    a.out = (float*)d_out; a.ws = (unsigned char*)d_ws;
#if MK_SINGLE
    a.ph_lo = 0; a.ph_hi = NPHASE;
    hipLaunchKernelGGL(mega_fwd, dim3(grid), dim3(512), LDS_BYTES, stream, a);
#else
    for (int p = 0; p < NPHASE; ++p) { a.ph_lo = p; a.ph_hi = p + 1; hipLaunchKernelGGL(mega_fwd, dim3(grid), dim3(512), LDS_BYTES, stream, a); }
#endif
}
```

```cpp
#include <hip/hip_runtime.h>
#include <cstdio>
#include <cstdint>
#include <cmath>

#define LAS __attribute__((address_space(3)))
#define GAS __attribute__((address_space(1)))
typedef unsigned short bf16_t;
typedef short bf16x8 __attribute__((ext_vector_type(8)));
typedef short s16x4 __attribute__((ext_vector_type(4)));
typedef float f32x4 __attribute__((ext_vector_type(4)));
typedef float f32x2 __attribute__((ext_vector_type(2)));
typedef __bf16 bf16x2_t __attribute__((ext_vector_type(2)));
typedef float f32x16 __attribute__((ext_vector_type(16)));
typedef unsigned u32x4 __attribute__((ext_vector_type(4)));
typedef unsigned u32x2 __attribute__((ext_vector_type(2)));
typedef int i32x4 __attribute__((ext_vector_type(4)));
typedef int i32x8 __attribute__((ext_vector_type(8)));
typedef GAS unsigned gu32;
#define RLX_AGENT __ATOMIC_RELAXED, __HIP_MEMORY_SCOPE_AGENT
#define DI __device__ __forceinline__

DI unsigned cvt_pk_bf16(float lo, float hi) { const f32x2 v = {lo, hi}; const bf16x2_t b = __builtin_convertvector(v, bf16x2_t); return __builtin_bit_cast(unsigned, b); }
DI float bf_lo(unsigned u) { return __uint_as_float(u << 16); }
DI float bf_hi(unsigned u) { return __uint_as_float(u & 0xffff0000u); }
DI float fast_exp2(float x) { return __builtin_amdgcn_exp2f(x); }
DI float fast_log2(float x) { return __builtin_amdgcn_logf(x); }
DI float fast_rcp(float x) { return __builtin_amdgcn_rcpf(x); }
DI float sigmoidf_(float x) { return fast_rcp(1.0f + fast_exp2(-1.4426950408889634f * x)); }

namespace pg8 {
constexpr int BM = 256, BK = 64, HALF = 128, HTB = HALF * BK * 2, STAGE_BYTES = 8 * HTB;
__host__ __device__ __forceinline__ int lds_byte(int r, int c) { const int st = (r >> 4) * 2 + (c >> 5), rr = r & 15, cc = c & 31, ob = rr * 64 + cc * 2; return st * 1024 + (ob ^ (((ob >> 9) & 1) << 5)); }
__host__ __device__ __forceinline__ void stage_rc(int b, int& R, int& C) { const int st = b / 1024, sb = b % 1024, swz = sb ^ (((sb >> 9) & 1) << 5); R = (st >> 1) * 16 + swz / 64; C = (st & 1) * 32 + (swz % 64) / 2; }
__host__ __device__ __forceinline__ int perm32(int rho) { const int n = rho >> 4, i = rho & 15; return 8 * (i >> 2) + 4 * n + (i & 3); }
struct Unit { int pm, pn, aux; };
template <int ES, class Epi, class Sched>
__device__ __forceinline__ void gemm_phase(LAS unsigned char* lds, const void* Abase_, const int K, const Sched& S, const Epi& E, int tid_in) {
    int tid_ = tid_in; asm volatile("" : "+v"(tid_));
    const int tid = tid_, wid = __builtin_amdgcn_readfirstlane(tid >> 6), lane = tid & 63, wr = wid >> 2, wc = wid & 3, fr = lane & 15, fq = lane >> 4;
    const int rowb = K * ES, nt = rowb / 128;
    const char* Abase = (const char*)Abase_;
    int Rr[2], Cc[2]; unsigned voffB[2];
#pragma unroll
    for (int i = 0; i < 2; ++i) { int R, C; stage_rc(tid * 16 + i * 8192, R, C); Rr[i] = R; Cc[i] = C; const int Rb = (R & ~31) + perm32(R & 31); voffB[i] = (unsigned)(Rb * rowb + C * 2); }
    const size_t kstep = (size_t)(BK * 2);
    const size_t hstep = (size_t)HALF * rowb;
    const size_t dPiece = (size_t)64 * rowb, dHalf = (size_t)HALF * rowb;
    const unsigned ldsw = (unsigned)wid * 1024u;
    const int aoff = lds_byte(wr * 64 + fr, (ES == 2) ? fq * 8 : fq * 16), boff = lds_byte(wc * 32 + fr, (ES == 2) ? fq * 8 : fq * 16);
    const int aoff1 = (ES == 2) ? aoff + 1024 : aoff + 16, boff1 = (ES == 2) ? boff + 1024 : boff + 16;
#define PG8_SA(b, h) (((b) * 2 + (h)) * HTB)
#define PG8_SB(b, h) ((4 + (b) * 2 + (h)) * HTB)
#define PG8_STAGE_B(bufoff, gbase) do { const char* _gb = (const char*)(gbase); asm volatile("" : "+s"(_gb)); _Pragma("unroll") for (int _i = 0; _i < 2; ++_i) \
        __builtin_amdgcn_global_load_lds((const unsigned*)(_gb + voffB[_i]), (LAS unsigned*)(lds + (bufoff) + ldsw + _i * 8192), 16, 0, 0); } while (0)
#define PG8_STAGE_A(bufoff, kb, o0, o1) do { const char* _ga = Abase + (size_t)(kb) + ((Sched::GATHER || ((bufoff) & HTB) == 0) ? (size_t)0 : dHalf); asm volatile("" : "+s"(_ga)); \
        const char* _gb2 = _ga + (Sched::GATHER ? (size_t)0 : dPiece); asm volatile("" : "+s"(_gb2)); \
        __builtin_amdgcn_global_load_lds((const unsigned*)(_ga + (o0)), (LAS unsigned*)(lds + (bufoff) + ldsw), 16, 0, 0); \
        __builtin_amdgcn_global_load_lds((const unsigned*)(_gb2 + (o1)), (LAS unsigned*)(lds + (bufoff) + ldsw + 8192), 16, 0, 0); } while (0)
#define PG8_CAT8(p0, p1) __builtin_shufflevector(*(const LAS i32x4*)(p0), *(const LAS i32x4*)(p1), 0, 1, 2, 3, 4, 5, 6, 7)
#define PG8_LDA(dst, b, h) do { if (ES == 2) { _Pragma("unroll") for (int m = 0; m < 4; ++m) _Pragma("unroll") for (int k = 0; k < 2; ++k) dst[m][k] = *(const LAS bf16x8*)(lds + PG8_SA(b, h) + (k ? aoff1 : aoff) + m * 2048); } \
        else { _Pragma("unroll") for (int m = 0; m < 4; ++m) dst##8[m] = PG8_CAT8(lds + PG8_SA(b, h) + aoff + m * 2048, lds + PG8_SA(b, h) + aoff1 + m * 2048); } } while (0)
#define PG8_LDB(dst, b, h) do { if (ES == 2) { _Pragma("unroll") for (int n = 0; n < 2; ++n) _Pragma("unroll") for (int k = 0; k < 2; ++k) dst[n][k] = *(const LAS bf16x8*)(lds + PG8_SB(b, h) + (k ? boff1 : boff) + n * 2048); } \
        else { _Pragma("unroll") for (int n = 0; n < 2; ++n) dst##8[n] = PG8_CAT8(lds + PG8_SB(b, h) + boff + n * 2048, lds + PG8_SB(b, h) + boff1 + n * 2048); } } while (0)
#define PG8_MMA(ai, bj, At, Bt) do { __builtin_amdgcn_s_setprio(1); _Pragma("unroll") for (int m = 0; m < 4; ++m) _Pragma("unroll") for (int n = 0; n < 2; ++n) { \
        if (ES == 2) { _Pragma("unroll") for (int k = 0; k < 2; ++k) acc[ai][bj][m][n] = __builtin_amdgcn_mfma_f32_16x16x32_bf16(Bt[n][k], At[m][k], acc[ai][bj][m][n], 0, 0, 0); } \
        else asm volatile("v_mfma_f32_16x16x128_f8f6f4 %0, %1, %2, %0" : "+v"(acc[ai][bj][m][n]) : "v"(Bt##8[n]), "v"(At##8[m])); }   \
        __builtin_amdgcn_s_setprio(0); } while (0)
#define PG8_WAIT_V(n) asm volatile("s_waitcnt vmcnt(" #n ")" ::: "memory")
#define PG8_WAIT_L(n) asm volatile("s_waitcnt lgkmcnt(" #n ")" ::: "memory")
#define PG8_BAR __builtin_amdgcn_s_barrier()
#define PG8_SCHED __builtin_amdgcn_sched_barrier(0)
    Unit cur, nxt; int ui = 0;
    if (!S.next(0, cur)) return;
    f32x4 acc[2][2][4][2];
    E.init(acc, cur, wc, fq);
    bf16x8 At[4][2], B0[2][2], B1[2][2];
    i32x8 At8[4], B08[2], B18[2];
    unsigned c00 = S.a_row_fin(S.a_row_raw(cur, Rr[0])) + Cc[0] * 2u, c01, c10, c11;
    if (Sched::GATHER) { c01 = S.a_row_fin(S.a_row_raw(cur, Rr[1])) + Cc[1] * 2u; c10 = S.a_row_fin(S.a_row_raw(cur, HALF + Rr[0])) + Cc[0] * 2u; c11 = S.a_row_fin(S.a_row_raw(cur, HALF + Rr[1])) + Cc[1] * 2u; }
    else { c01 = c00; c10 = c00; c11 = c00; }
    unsigned n00 = c00, n01 = c01, n10 = c10, n11 = c11;
    const char* cB = S.b_tile(cur); const char* nB = cB;
    Unit nn; bool have_nxt = S.next(1, nxt);
    unsigned r0 = 0u, r1 = 0u, r2 = 0u, r3 = 0u;
    if (Sched::GATHER && have_nxt) { r0 = S.a_row_raw(nxt, Rr[0]); r1 = S.a_row_raw(nxt, Rr[1]); r2 = S.a_row_raw(nxt, HALF + Rr[0]); r3 = S.a_row_raw(nxt, HALF + Rr[1]); }
    PG8_STAGE_B(PG8_SB(0, 0), cB); PG8_STAGE_B(PG8_SB(0, 1), cB + hstep); PG8_STAGE_A(PG8_SA(0, 0), 0, c00, c01); PG8_STAGE_A(PG8_SA(0, 1), 0, c10, c11);
    if (wr == 1) PG8_BAR;
    PG8_WAIT_V(2); PG8_BAR;
    PG8_STAGE_B(PG8_SB(1, 0), cB + kstep); PG8_STAGE_A(PG8_SA(1, 0), kstep, c00, c01); PG8_STAGE_B(PG8_SB(1, 1), cB + hstep + kstep);
    PG8_WAIT_V(6); PG8_BAR;
    for (;;) {
        const bool has_next = have_nxt;
        if (has_next) {
            if (Sched::GATHER) { n00 = S.a_row_fin(r0) + Cc[0] * 2u; n01 = S.a_row_fin(r1) + Cc[1] * 2u; n10 = S.a_row_fin(r2) + Cc[0] * 2u; n11 = S.a_row_fin(r3) + Cc[1] * 2u; }
            else { n00 = S.a_row_fin(S.a_row_raw(nxt, Rr[0])) + Cc[0] * 2u; n01 = n00; n10 = n00; n11 = n00; }
            nB = S.b_tile(nxt); }
        else { n00 = c00; n01 = c01; n10 = c10; n11 = c11; nB = cB; }
        const bool have_nn = has_next && S.next(ui + 2, nn);
        if (Sched::GATHER && have_nn) { r0 = S.a_row_raw(nn, Rr[0]); r1 = S.a_row_raw(nn, Rr[1]); r2 = S.a_row_raw(nn, HALF + Rr[0]); r3 = S.a_row_raw(nn, HALF + Rr[1]); }
        for (int t = 0; t < nt; t += 2) {
            const bool last = (t == nt - 2);
            const size_t k1 = (size_t)(t + 1) * kstep;
            const size_t k2 = last ? 0 : (size_t)(t + 2) * kstep, k3 = k2 + kstep;
            const char* b2 = last ? nB : cB + (size_t)(t + 2) * kstep; const char* b3 = b2 + kstep;
            const unsigned o00 = last ? n00 : c00, o01 = last ? n01 : c01, o10 = last ? n10 : c10, o11 = last ? n11 : c11;
            PG8_LDB(B0, 0, 0); PG8_LDB(B1, 0, 1); PG8_SCHED; PG8_LDA(At, 0, 0); PG8_STAGE_A(PG8_SA(1, 1), k1, c10, c11);
            PG8_WAIT_V(8); PG8_WAIT_L(0); PG8_BAR; PG8_MMA(0, 0, At, B0); PG8_MMA(0, 1, At, B1); PG8_BAR; PG8_SCHED;
            PG8_LDA(At, 0, 1); PG8_STAGE_B(PG8_SB(0, 0), b2); PG8_STAGE_B(PG8_SB(0, 1), b2 + hstep); PG8_STAGE_A(PG8_SA(0, 0), k2, o00, o01);
            PG8_WAIT_V(8); PG8_WAIT_L(0); PG8_BAR; PG8_MMA(1, 0, At, B0); PG8_MMA(1, 1, At, B1); PG8_BAR; PG8_SCHED;
            PG8_LDB(B0, 1, 0); PG8_LDB(B1, 1, 1); PG8_SCHED; PG8_LDA(At, 1, 0); PG8_STAGE_A(PG8_SA(0, 1), k2, o10, o11);
            PG8_WAIT_V(8); PG8_WAIT_L(0); PG8_BAR; PG8_MMA(0, 0, At, B0); PG8_MMA(0, 1, At, B1); PG8_BAR; PG8_SCHED;
            PG8_LDA(At, 1, 1); PG8_STAGE_B(PG8_SB(1, 0), b3); PG8_STAGE_B(PG8_SB(1, 1), b3 + hstep); PG8_STAGE_A(PG8_SA(1, 0), k3, o00, o01);
            PG8_WAIT_V(8); PG8_WAIT_L(0); PG8_BAR; PG8_MMA(1, 0, At, B0); PG8_MMA(1, 1, At, B1); PG8_BAR; PG8_SCHED;
        }
        if (wr == 0) PG8_BAR;
        if (ES == 1) asm volatile("s_nop 15\n\ts_nop 7" ::: "memory");
        E(acc, cur, wr, wc, fr, fq);
        if (!has_next) break;
        E.init(acc, nxt, wc, fq);
        if (ES == 1) asm volatile("s_nop 7" ::: "memory");
        cur = nxt; c00 = n00; c01 = n01; c10 = n10; c11 = n11; cB = nB; ++ui; nxt = nn; have_nxt = have_nn;
        if (wr == 1) PG8_BAR;
    }
    PG8_WAIT_V(0);
    PG8_BAR;
#undef PG8_SA
#undef PG8_SB
#undef PG8_STAGE_A
#undef PG8_STAGE_B
#undef PG8_LDA
#undef PG8_LDB
#undef PG8_MMA
#undef PG8_WAIT_V
#undef PG8_WAIT_L
#undef PG8_BAR
#undef PG8_SCHED
}
}
#define XB_TMO      128
#define XB_XCNT(j)  (256  + 64 * (j))
#define XB_XSUB(j)  (1280 + 64 * (j))
#define XB_XGEN(j)  (2304 + 64 * (j))
#define XB_TOP      3328
#define XB_TOPGEN   3392
#define XCD_BAR_WORDS 3456
#define XB_SPIN_CAP (1u << 18)

__device__ __forceinline__ unsigned xb_ld(unsigned* p)              { return __hip_atomic_load(p, __ATOMIC_RELAXED, __HIP_MEMORY_SCOPE_AGENT); }
__device__ __forceinline__ unsigned xb_add(unsigned* p, unsigned v) { return __hip_atomic_fetch_add(p, v, __ATOMIC_RELAXED, __HIP_MEMORY_SCOPE_AGENT); }
__device__ __forceinline__ unsigned xb_xcc_id() { return (unsigned)__builtin_amdgcn_s_getreg((3 << 11) | 20) & 0xFu; }
#define XB_SPIN(cond, bar) do { unsigned _sp = 0; while (cond) { __builtin_amdgcn_s_sleep(1); \
    if ((++_sp & 255u) == 0u) { if (xb_ld(&(bar)[XB_TMO])) break; if (_sp > XB_SPIN_CAP) { atomicAdd(&(bar)[XB_TMO], 1u); break; } } } } while (0)

struct XcdBarrier {
    unsigned* bar; unsigned x; int wv;
    volatile LAS unsigned* st;
};

__device__ __forceinline__ XcdBarrier xcd_barrier_post(unsigned* bar, volatile LAS unsigned* st) {
    XcdBarrier b; b.bar = bar; b.x = xb_xcc_id(); b.st = st; b.wv = 0;
    if (threadIdx.x == 0) (void)xb_add(&bar[XB_XCNT(b.x)], 1u);
    return b;
}
__device__ __forceinline__ void xcd_barrier_complete(unsigned* bar, unsigned x, unsigned& nloc, unsigned& nx) {
    const unsigned G = gridDim.x * gridDim.y * gridDim.z;
    unsigned sum, cnt, mine, sp = 0u;
    for (;;) {
        sum = 0u; cnt = 0u; mine = 0u;
#pragma unroll
        for (unsigned j = 0; j < 16; ++j) { const unsigned c = xb_ld(&bar[XB_XCNT(j)]); sum += c; cnt += (c > 0u) ? 1u : 0u; mine = (j == x) ? c : mine; }
        if (sum == G) break;
        __builtin_amdgcn_s_sleep(1);
        if ((++sp & 255u) == 0u) { if (xb_ld(&bar[XB_TMO])) break; if (sp > XB_SPIN_CAP) { atomicAdd(&bar[XB_TMO], 1u); break; } }
    }
    nloc = mine > 0u ? mine : 1u; nx = cnt > 0u ? cnt : 1u;
}

__device__ __forceinline__ void xcd_barrier(const XcdBarrier& b) {
    asm volatile("s_waitcnt vmcnt(0)" ::: "memory");
    __syncthreads();
    if (b.wv == 0 && __builtin_amdgcn_mbcnt_hi(~0u, __builtin_amdgcn_mbcnt_lo(~0u, 0u)) == 0u) {
        unsigned* bar = b.bar;
        __builtin_amdgcn_s_waitcnt(0);
        unsigned nloc = b.st[0], nx = b.st[1];
        if (nloc == 0u) { xcd_barrier_complete(bar, b.x, nloc, nx); b.st[0] = nloc; b.st[1] = nx; }
        const unsigned old = xb_add(&bar[XB_XSUB(b.x)], 1u);
        const unsigned gen = old / nloc;
        if (old + 1u == (gen + 1u) * nloc) {
            __builtin_amdgcn_fence(__ATOMIC_RELEASE, "agent");
            asm volatile("s_waitcnt vmcnt(0)" ::: "memory");
            const unsigned og = xb_add(&bar[XB_TOP], 1u);
            const unsigned tg = og / nx;
            if (og + 1u == (tg + 1u) * nx) xb_add(&bar[XB_TOPGEN], 1u);
            else XB_SPIN(xb_ld(&bar[XB_TOPGEN]) == tg, bar);
            __builtin_amdgcn_fence(__ATOMIC_ACQUIRE, "agent");
            xb_add(&bar[XB_XGEN(b.x)], 1u);
            asm volatile("s_waitcnt vmcnt(0)" ::: "memory");
        } else {
            XB_SPIN(xb_ld(&bar[XB_XGEN(b.x)]) == gen, bar);
            __builtin_amdgcn_fence(__ATOMIC_ACQUIRE, "agent");
            asm volatile("s_waitcnt vmcnt(0)" ::: "memory");
        }
    }
    __syncthreads();
}

constexpr int NB = 8, SEQ = 8192, DM = 1024, NTOK = NB * SEQ, DEPTH = 2;
constexpr int NHA = 8, KVR = 128, NIH = 4, IDXD = 64, TOPK = 256, NHB = 8, HD = 64;
constexpr int NEXP = 32, MTOPK = 4, DEXP = 1024;
constexpr int NCOLS_SRC = 4548, NCOL = 5120;
constexpr int SRC_CKV = 512, SRC_QIDX = 640, SRC_KIDX = 896, SRC_WIDX = 960, SRC_QB = 964, SRC_KB = 1476, SRC_VB = 1988, SRC_GA = 2500, SRC_GB = 3524;
constexpr int PC_QLAT = 0, PC_MISC = 1024, PC_QIDX = 1280, PC_QB = 1536, PC_KB = 2048, PC_VB = 2560, PC_GA = 3072, PC_GB = 4096;
constexpr float LN_EPS = 1e-5f, RMS_EPS = 1e-6f;
constexpr float DN_ALPHA = 1.4142135623730951f;
constexpr float LOG2E = 1.4426950408889634f;
constexpr float SB_QSCALE = 0.125f * LOG2E;
constexpr float SB_STOP = 48.0f;
constexpr int ACT_ROWS = NTOK * MTOPK + NEXP * 256;
constexpr float WGU_SCALE = 32.0f, WDN_SCALE = 64.0f, WIN_SCALE = 32.0f, WQL_SCALE = 256.0f, WFA_SCALE = 128.0f, WB_SCALE = 32.0f, WO_SCALE = 64.0f;
constexpr float OLAT_SCALE = 8.0f, OB_SCALE = 8.0f, MG_SCALE = 16.0f;

constexpr size_t MiB = 1u << 20;
constexpr size_t WS_CTL = 0, CTL_ZERO_BYTES = 1 * MiB;
constexpr size_t WS_MOD = 1 * MiB, WS_WIDX = 2 * MiB, WS_GATE = 3 * MiB, WS_LIST = 4 * MiB;
constexpr size_t WS_WIN = 12 * MiB, WS_WFA = 32 * MiB, WS_WB = 36 * MiB, WS_WO = 38 * MiB, WS_WGU = 42 * MiB, WS_WDN = 298 * MiB;
constexpr size_t WS_CKV = 426 * MiB, WS_KIDX = 442 * MiB, WS_H = 450 * MiB, WS_ZX = 578 * MiB, WS_XB = 706 * MiB;
constexpr size_t WS_P = 834 * MiB, WS_ACT = 834 * MiB;
constexpr size_t WS_OLAT = 1474 * MiB, WS_OB = 1602 * MiB, WS_T = 1666 * MiB, WS_MISC = 1666 * MiB, WS_MERGED = 1794 * MiB, WS_YS = 1474 * MiB;
constexpr size_t WS_GATEL = 1986 * MiB;
constexpr size_t WS_END = 1994 * MiB;
static_assert(WS_ACT + (size_t)ACT_ROWS * DEXP * 2 <= WS_OLAT, "ACT fits in R1");
static_assert(WS_P + (size_t)NTOK * NCOL * 2 <= WS_OLAT, "P fits in R1");
constexpr int CW_BAR = 4096;
constexpr int CW_CNT = 8192;
constexpr int CW_DSAQ = 9216;

constexpr int LDS_BYTES = 163840;
constexpr int MISC_OFF = LDS_BYTES - 512;
constexpr int SCH_OFF = LDS_BYTES - 1024;

#define LDS_WAIT() asm volatile("s_waitcnt lgkmcnt(0)" ::: "memory")
#define VM_WAIT() asm volatile("s_waitcnt vmcnt(0)" ::: "memory")

#define DPPF(v, ctrl) __uint_as_float((unsigned)__builtin_amdgcn_update_dpp(0, (int)__float_as_uint(v), (ctrl), 0xf, 0xf, false))
DI float wave_sum(float v) {
    v += DPPF(v, 0xB1); v += DPPF(v, 0x4E); v += DPPF(v, 0x141); v += DPPF(v, 0x140);
    const float r0 = __uint_as_float((unsigned)__builtin_amdgcn_readlane((int)__float_as_uint(v), 0)), r1 = __uint_as_float((unsigned)__builtin_amdgcn_readlane((int)__float_as_uint(v), 16));
    const float r2 = __uint_as_float((unsigned)__builtin_amdgcn_readlane((int)__float_as_uint(v), 32)), r3 = __uint_as_float((unsigned)__builtin_amdgcn_readlane((int)__float_as_uint(v), 48));
    return (r0 + r1) + (r2 + r3);
}

struct Ctx {
    LAS unsigned char* lds;
    int tid, lane, wave, vcu, G;
    const float *x, *c, *rel_bias, *w_ada, *b_ada, *w_in, *g_kv, *w_uk, *w_uv, *w_a_out, *w_b_out, *w_o, *ln1_g, *ln1_b, *w_router, *b_router, *w_gu, *b_gu, *w_dn, *b_dn, *ln2_g, *ln2_b;
    float* out; unsigned char* ws; gu32* ctl;
};

template <class Map>
DI void transpose_item(const float* W, int K, int Nsrc, bf16_t* WT, LAS float* scr, int item, int nblk_dst, int lane, const Map& map) {
    const int kb = item / nblk_dst, nb = item % nblk_dst, k0 = 128 * kb, n0 = 32 * nb;
    const int sc = map(n0 + (lane & 31));
    float tv[64];
    const float* src = W + (size_t)(k0 + (lane >> 5)) * Nsrc + (sc >= 0 ? sc : 0);
#pragma unroll
    for (int i = 0; i < 64; ++i) tv[i] = __builtin_nontemporal_load(src + (size_t)(2 * i) * Nsrc);
#pragma unroll
    for (int i = 0; i < 64; ++i) scr[(2 * i + (lane >> 5)) * 33 + (lane & 31)] = (sc >= 0) ? tv[i] : 0.f;
    LDS_WAIT(); asm volatile("" ::: "memory");
    const int c = lane & 15;
#pragma unroll
    for (int j = 0; j < 8; ++j) { const int n = (lane >> 4) + 4 * j; const LAS float* s = scr + (8 * c) * 33 + n;
        u32x4 o; o.x = cvt_pk_bf16(s[0 * 33], s[1 * 33]); o.y = cvt_pk_bf16(s[2 * 33], s[3 * 33]); o.z = cvt_pk_bf16(s[4 * 33], s[5 * 33]); o.w = cvt_pk_bf16(s[6 * 33], s[7 * 33]);
        *(GAS u32x4*)(WT + (size_t)(n0 + n) * K + k0 + 8 * c) = o; }
    LDS_WAIT(); asm volatile("" ::: "memory");
}
DI unsigned pack_fp8x4(float a, float b, float c, float d) {
    unsigned p = (unsigned)__builtin_amdgcn_cvt_pk_fp8_f32(a, b, 0, false);
    return (unsigned)__builtin_amdgcn_cvt_pk_fp8_f32(c, d, (int)p, true);
}
template <class Map>
DI void transpose_item_fp8(const float* W, int K, int Nsrc, unsigned char* WT, LAS float* scr, int item, int nblk_dst, int lane, const Map& map, float scale) {
    const int kb = item / nblk_dst, nb = item % nblk_dst, k0 = 128 * kb, n0 = 32 * nb;
    const int sc = map(n0 + (lane & 31));
    float tv[64];
    const float* src = W + (size_t)(k0 + (lane >> 5)) * Nsrc + (sc >= 0 ? sc : 0);
#pragma unroll
    for (int i = 0; i < 64; ++i) tv[i] = __builtin_nontemporal_load(src + (size_t)(2 * i) * Nsrc);
#pragma unroll
    for (int i = 0; i < 64; ++i) scr[(2 * i + (lane >> 5)) * 33 + (lane & 31)] = (sc >= 0) ? tv[i] * scale : 0.f;
    LDS_WAIT(); asm volatile("" ::: "memory");
    const int c = lane & 15;
#pragma unroll
    for (int j = 0; j < 8; ++j) { const int n = (lane >> 4) + 4 * j; const LAS float* s = scr + (8 * c) * 33 + n;
        u32x2 o; o.x = pack_fp8x4(s[0 * 33], s[1 * 33], s[2 * 33], s[3 * 33]); o.y = pack_fp8x4(s[4 * 33], s[5 * 33], s[6 * 33], s[7 * 33]);
        *(GAS u32x2*)(WT + (size_t)(n0 + n) * K + k0 + 8 * c) = o; }
    LDS_WAIT(); asm volatile("" ::: "memory");
}
struct MapIn {
    DI int operator()(int n) const {
        if (n < 1152) return SRC_CKV + (n - 1024);
        if (n < 1216) return SRC_KIDX + (n - 1152);
        if (n < 1220) return SRC_WIDX + (n - 1216);
        if (n < 1280) return -1;
        if (n < 1536) return SRC_QIDX + (n - 1280);
        if (n < 2048) return SRC_QB + (n - 1536);
        if (n < 2560) return SRC_KB + (n - 2048);
        if (n < 3072) return SRC_VB + (n - 2560);
        if (n < 4096) return SRC_GA + (n - 3072);
        return SRC_GB + (n - 4096);
    }
};
struct MapGU { DI int operator()(int n) const { const int t = n >> 8, w = n & 255; return (w < 128) ? (t * 128 + w) : (1024 + t * 128 + (w - 128)); } };
struct MapId { DI int operator()(int n) const { return n; } };

DI void p0_prologue(Ctx& F) {
    LAS float* scr = (LAS float*)(F.lds + F.wave * 16896);
    const int gw = F.vcu * 8 + F.wave, NGW = F.G * 8;
    constexpr int I_IN = 8 * 128, I_GU = 8 * 64, I_DN = 8 * 32, I_B = 4 * 32, I_O = 8 * 32;
    constexpr int T_IN = DEPTH * I_IN, T_GU = DEPTH * NEXP * I_GU, T_DN = DEPTH * NEXP * I_DN, T_B = DEPTH * I_B, T_O = DEPTH * I_O;
    constexpr int NITEMS = T_IN + T_GU + T_DN + T_B + T_O;
    for (int it = gw; it < NITEMS; it += NGW) {
        int r = it;
        if (r < T_GU) { const int m = r / I_GU; transpose_item_fp8(F.w_gu + (size_t)m * 1024 * 2048, 1024, 2048, (unsigned char*)(F.ws + WS_WGU) + (size_t)m * 2048 * 1024, scr, r % I_GU, 64, F.lane, MapGU(), WGU_SCALE); continue; } r -= T_GU;
        if (r < T_DN) { const int m = r / I_DN; transpose_item_fp8(F.w_dn + (size_t)m * 1024 * 1024, 1024, 1024, (unsigned char*)(F.ws + WS_WDN) + (size_t)m * 1024 * 1024, scr, r % I_DN, 32, F.lane, MapId(), WDN_SCALE); continue; } r -= T_DN;
        if (r < T_IN) { const int l = r / I_IN; const int q = r % I_IN; const int kb = q / 128, nb = q % 128;
            struct M2 { DI int operator()(int n) const { return MapIn()(n + 1024); } };
            transpose_item_fp8(F.w_in + (size_t)l * 1024 * NCOLS_SRC, 1024, NCOLS_SRC, (unsigned char*)(F.ws + WS_WIN) + (size_t)l * NCOL * 1024 + (size_t)1024 * 1024, scr, kb * 128 + nb, 128, F.lane, M2(), WIN_SCALE); continue; } r -= T_IN;
        if (r < T_B) { const int l = r / I_B; transpose_item_fp8(F.w_b_out + (size_t)l * 512 * 1024, 512, 1024, (unsigned char*)(F.ws + WS_WB) + (size_t)l * 1024 * 512, scr, r % I_B, 32, F.lane, MapId(), WB_SCALE); continue; } r -= T_B;
        { const int l = r / I_O; transpose_item_fp8(F.w_o + (size_t)l * 1024 * 1024, 1024, 1024, (unsigned char*)(F.ws + WS_WO) + (size_t)l * 1024 * 1024, scr, r % I_O, 32, F.lane, MapId(), WO_SCALE); }
    }
    __syncthreads();
    LAS float* As = (LAS float*)F.lds;
    LAS float* Bs = (LAS float*)(F.lds + 128 * 65 * 4);
    constexpr int J_QL = DEPTH * 8 * 16, J_FA = DEPTH * 8 * 16, J_MOD = DEPTH * 96;
    for (int j = F.vcu; j < J_QL + J_FA + J_MOD; j += F.G) {
        if (j < J_QL) {
            const int l = j / 128, h = (j % 128) / 16, k0 = ((j % 128) % 16) * 64;
            for (int u = F.tid; u < 128 * 64; u += 512) { const int r = u >> 6, d = u & 63; As[r * 65 + d] = F.w_uk[(((size_t)l * 128 + r) * 8 + h) * 64 + d]; }
            for (int u = F.tid; u < 64 * 64; u += 512) { const int k = u >> 6, d = u & 63; Bs[k * 65 + d] = F.w_in[((size_t)l * 1024 + k0 + k) * NCOLS_SRC + h * 64 + d]; }
            __syncthreads();
            unsigned char* dst = (unsigned char*)(F.ws + WS_WIN) + (size_t)l * NCOL * 1024;
            { const int rt = F.wave >> 1, kt = F.wave & 1, r32 = F.lane & 31, hi = F.lane >> 5;
              f32x16 acc;
#pragma unroll
              for (int i = 0; i < 16; ++i) acc[i] = 0.f;
#pragma unroll 8
              for (int st = 0; st < 32; ++st) acc = __builtin_amdgcn_mfma_f32_32x32x2f32(As[(rt * 32 + r32) * 65 + 2 * st + hi], Bs[(kt * 32 + r32) * 65 + 2 * st + hi], acc, 0, 0, 0);
#pragma unroll
              for (int i = 0; i < 16; ++i) { const int r = rt * 32 + (i & 3) + 8 * (i >> 2) + 4 * hi, k = kt * 32 + r32;
                  dst[(size_t)(h * 128 + r) * 1024 + k0 + k] = (unsigned char)(pack_fp8x4(0.125f * WQL_SCALE * acc[i], 0.f, 0.f, 0.f) & 0xffu); } }
            __syncthreads();
        } else if (j < J_QL + J_FA) {
            const int jj = j - J_QL; const int l = jj / 128, h = (jj % 128) / 16, n0 = ((jj % 128) % 16) * 64;
            for (int u = F.tid; u < 128 * 64; u += 512) { const int r = u >> 6, d = u & 63; As[r * 65 + d] = F.w_uv[(((size_t)l * 128 + r) * 8 + h) * 64 + d]; }
            for (int u = F.tid; u < 64 * 64; u += 512) { const int d = u >> 6, n = u & 63; Bs[d * 65 + n] = F.w_a_out[((size_t)l * 512 + h * 64 + d) * 1024 + n0 + n]; }
            __syncthreads();
            unsigned char* dst = (unsigned char*)(F.ws + WS_WFA) + (size_t)l * 1024 * 1024;
            { const int rt = F.wave >> 1, nt = F.wave & 1, r32 = F.lane & 31, hi = F.lane >> 5;
              f32x16 acc;
#pragma unroll
              for (int i = 0; i < 16; ++i) acc[i] = 0.f;
#pragma unroll 8
              for (int st = 0; st < 32; ++st) acc = __builtin_amdgcn_mfma_f32_32x32x2f32(As[(rt * 32 + r32) * 65 + 2 * st + hi], Bs[(2 * st + hi) * 65 + nt * 32 + r32], acc, 0, 0, 0);
#pragma unroll
              for (int i = 0; i < 16; ++i) { const int r = rt * 32 + (i & 3) + 8 * (i >> 2) + 4 * hi, n = nt * 32 + r32;
                  dst[(size_t)(n0 + n) * 1024 + h * 128 + r] = (unsigned char)(pack_fp8x4(WFA_SCALE * acc[i], 0.f, 0.f, 0.f) & 0xffu); } }
            __syncthreads();
        } else {
            const int jj = j - J_QL - J_FA; const int l = jj / 96, cg = jj % 96;
            LAS float* sc = (LAS float*)F.lds;
            LAS float* part = (LAS float*)(F.lds + 32768);
            for (int u = F.tid; u < 8 * 1024; u += 512) { const float v = F.c[u]; sc[u] = v * sigmoidf_(v); }
            __syncthreads();
            const int col = F.tid & 63, ks = F.tid >> 6;
            float a[8];
#pragma unroll
            for (int b = 0; b < 8; ++b) a[b] = 0.f;
            const float* wp = F.w_ada + ((size_t)l * 1024 + ks * 128) * 6144 + cg * 64 + col;
            for (int k = 0; k < 128; ++k) { const float w = wp[(size_t)k * 6144];
#pragma unroll
                for (int b = 0; b < 8; ++b) a[b] += sc[b * 1024 + ks * 128 + k] * w; }
#pragma unroll
            for (int b = 0; b < 8; ++b) part[(ks * 8 + b) * 64 + col] = a[b];
            __syncthreads();
            { const int b = F.tid >> 6; float s = F.b_ada[(size_t)l * 6144 + cg * 64 + col];
#pragma unroll
              for (int k2 = 0; k2 < 8; ++k2) s += part[(k2 * 8 + b) * 64 + col];
              ((float*)(F.ws + WS_MOD))[((size_t)l * 8 + b) * 6144 + cg * 64 + col] = s; }
            __syncthreads();
        }
    }
}

DI void load_row(const float* p, int lane, f32x4 (&v)[4]) {
#pragma unroll
    for (int j = 0; j < 4; ++j) v[j] = __builtin_nontemporal_load((const GAS f32x4*)p + lane + 64 * j);
}
DI void load_row_bf16(const bf16_t* p, int lane, f32x4 (&v)[4]) {
#pragma unroll
    for (int j = 0; j < 4; ++j) { const u32x2 w = *((const GAS u32x2*)p + lane + 64 * j); v[j] = (f32x4){bf_lo(w.x), bf_hi(w.x), bf_lo(w.y), bf_hi(w.y)}; }
}
DI void ln_stats(const f32x4 (&v)[4], float& mean, float& rstd) {
    float s = 0.f;
#pragma unroll
    for (int j = 0; j < 4; ++j) s += (v[j].x + v[j].y) + (v[j].z + v[j].w);
    mean = wave_sum(s) * (1.f / DM); float s2 = 0.f;
#pragma unroll
    for (int j = 0; j < 4; ++j) { const f32x4 d = v[j] - mean; s2 += (d.x * d.x + d.y * d.y) + (d.z * d.z + d.w * d.w); }
    rstd = 1.f / sqrtf(wave_sum(s2) * (1.f / DM) + LN_EPS);
}
DI void modulate_store(const f32x4 (&v)[4], const float* shift, const float* scale, unsigned char* orow, int lane) {
    float mean, rstd; ln_stats(v, mean, rstd);
#pragma unroll
    for (int j = 0; j < 4; ++j) {
        const f32x4 sh = *((const GAS f32x4*)shift + lane + 64 * j), sc = *((const GAS f32x4*)scale + lane + 64 * j);
        const f32x4 o = (v[j] - mean) * rstd * (sc + 1.0f) + sh;
        *((GAS unsigned*)orow + lane + 64 * j) = pack_fp8x4(o.x, o.y, o.z, o.w);
    }
}

struct DenseSched {
    static constexpr bool GATHER = false;
    int nM, nN, nwg, G, c, K; const char* Bt;
    DI void init(int M, int N, int Kbytes, const void* Bt_, int G_, int c_) { nM = M / 256; nN = N / 256; nwg = nM * nN; G = G_; c = c_; K = Kbytes; Bt = (const char*)Bt_; }
    DI bool next(int i, pg8::Unit& u) const {
        const long L = (long)i * G + c; if (L >= nwg) return false;
        int wgid = (int)L; { const int q = nwg / 8, r = nwg % 8, xcd = wgid % 8, off = wgid / 8; wgid = (xcd < r ? xcd * (q + 1) : r * (q + 1) + (xcd - r) * q) + off; }
        const int nig = 8 * nN, gid = wgid / nig, fm = gid * 8, gsz = (nM - fm) < 8 ? (nM - fm) : 8;
        u.pm = fm + ((wgid % nig) % gsz); u.pn = (wgid % nig) / gsz; u.aux = 0; return true;
    }
    DI unsigned a_row_raw(const pg8::Unit& u, int row) const { return (unsigned)(u.pm * 256 + row) * (unsigned)K; }
    DI unsigned a_row_fin(unsigned raw) const { return raw; }
    DI const char* b_tile(const pg8::Unit& u) const { return Bt + (size_t)__builtin_amdgcn_readfirstlane(u.pn) * 256 * K; }
};
template <bool GATHER_>
struct MoeSched {
    static constexpr bool GATHER = GATHER_; static constexpr bool gather = GATHER_;
    const LAS int* tstart; const LAS int* cnt; int NCT, ntiles, G, c; const char* Bt; const unsigned* list;
    DI bool next(int i, pg8::Unit& u) const {
        int gt, ct;
        if ((G & 7) == 0) { const int nb = G >> 3, x = c & 7, j = c >> 3, uu = i * nb + j; gt = (uu / NCT) * 8 + x; ct = uu % NCT; if (gt >= ntiles) return false; }
        else { const long L = (long)i * G + c; if (L >= (long)ntiles * NCT) return false; gt = (int)(L / NCT); ct = (int)(L % NCT); }
        int e = -1;
#pragma unroll
        for (int h = 0; h < 2; ++h) { const i32x4 a = *(const LAS i32x4*)(tstart + 16 * h), b = *(const LAS i32x4*)(tstart + 16 * h + 4), c4 = *(const LAS i32x4*)(tstart + 16 * h + 8), d = *(const LAS i32x4*)(tstart + 16 * h + 12);
            e += ((a.x <= gt) + (a.y <= gt)) + ((a.z <= gt) + (a.w <= gt)) + ((b.x <= gt) + (b.y <= gt)) + ((b.z <= gt) + (b.w <= gt))
               + ((c4.x <= gt) + (c4.y <= gt)) + ((c4.z <= gt) + (c4.w <= gt)) + ((d.x <= gt) + (d.y <= gt)) + ((d.z <= gt) + (d.w <= gt)); }
        u.pm = __builtin_amdgcn_readfirstlane(gt); u.pn = __builtin_amdgcn_readfirstlane(ct); u.aux = __builtin_amdgcn_readfirstlane(e); return true;
    }
    DI unsigned a_row_raw(const pg8::Unit& u, int row) const {
        if (!gather) return (unsigned)(u.pm * 256 + row) << 2;
        int lr = (u.pm - tstart[u.aux]) * 256 + row; const int n = cnt[u.aux]; lr = lr < n ? lr : n - 1;
        return list[(size_t)u.aux * NTOK + lr];
    }
    DI unsigned a_row_fin(unsigned raw) const { return (raw >> 2) * 1024u; }
    DI const char* b_tile(const pg8::Unit& u) const { return Bt + ((size_t)__builtin_amdgcn_readfirstlane(u.aux * NCT + u.pn)) * 256 * 1024; }
};

#define EPI_ROWS(...) _Pragma("unroll") for (int ai = 0; ai < 2; ++ai) _Pragma("unroll") for (int m = 0; m < 4; ++m) { const int row = u.pm * 256 + ai * 128 + wr * 64 + m * 16 + fr; \
        _Pragma("unroll") for (int bj = 0; bj < 2; ++bj) { const int col = u.pn * 256 + bj * 128 + wc * 32 + 8 * fq; const f32x4 v0 = acc[ai][bj][m][0], v1 = acc[ai][bj][m][1]; __VA_ARGS__ } if (((ai * 4 + m) & 3) == 3) asm volatile("" ::: "memory"); }
DI u32x4 pack8(const f32x4 a, const f32x4 b) { u32x4 w; w.x = cvt_pk_bf16(a[0], a[1]); w.y = cvt_pk_bf16(a[2], a[3]); w.z = cvt_pk_bf16(b[0], b[1]); w.w = cvt_pk_bf16(b[2], b[3]); return w; }
DI void unpack8(const u32x4 w, f32x4& a, f32x4& b) { a = (f32x4){bf_lo(w.x), bf_hi(w.x), bf_lo(w.y), bf_hi(w.y)}; b = (f32x4){bf_lo(w.z), bf_hi(w.z), bf_lo(w.w), bf_hi(w.w)}; }

DI void unpack8_fp8(const u32x2 w, f32x4& a, f32x4& b) {
    const f32x2 a0 = __builtin_amdgcn_cvt_pk_f32_fp8((int)w.x, false), a1 = __builtin_amdgcn_cvt_pk_f32_fp8((int)w.x, true), b0 = __builtin_amdgcn_cvt_pk_f32_fp8((int)w.y, false), b1 = __builtin_amdgcn_cvt_pk_f32_fp8((int)w.y, true);
    a = (f32x4){a0.x, a0.y, a1.x, a1.y}; b = (f32x4){b0.x, b0.y, b1.x, b1.y};
}
constexpr float GATE_SCALE = 256.0f, T_SCALE = 16.0f, QLAT8_SCALE = 16.0f;
DI const unsigned char* gate8_ptr(const bf16_t* P, int row, int g) { return (const unsigned char*)P + (size_t)row * (NCOL * 2) + 6144 + g; }
struct EpiInProj {
    bf16_t* P; float* MISC;
    DI void init(f32x4 (&acc)[2][2][4][2], const pg8::Unit&, int, int) const {
#pragma unroll
        for (int a = 0; a < 2; ++a)
#pragma unroll
            for (int b = 0; b < 2; ++b)
#pragma unroll
                for (int m = 0; m < 4; ++m)
#pragma unroll
                    for (int n = 0; n < 2; ++n) acc[a][b][m][n] = (f32x4){0.f, 0.f, 0.f, 0.f};
    }
    DI void operator()(const f32x4 (&acc)[2][2][4][2], const pg8::Unit& u, int wr, int wc, int fr, int fq) const {
        const int pn = u.pn;
        const float ws = (pn < 4) ? (1.0f / WQL_SCALE) : (1.0f / WIN_SCALE);
        if (pn == 4) {
            EPI_ROWS( float* o = MISC + (size_t)row * 256 + (col - PC_MISC); *(f32x4*)o = v0 * ws; *(f32x4*)(o + 4) = v1 * ws; )
        } else if (pn >= 12) {
            EPI_ROWS( f32x4 a, b;
                _Pragma("unroll") for (int q = 0; q < 4; ++q) { a[q] = sigmoidf_(v0[q] * ws) * GATE_SCALE; b[q] = sigmoidf_(v1[q] * ws) * GATE_SCALE; }
                u32x2 w; w.x = pack_fp8x4(a[0], a[1], a[2], a[3]); w.y = pack_fp8x4(b[0], b[1], b[2], b[3]);
                *(u32x2*)(const_cast<unsigned char*>(gate8_ptr(P, row, col - PC_GA))) = w; )
        } else if (pn < 4) {
            const float sc = ws * QLAT8_SCALE;
            EPI_ROWS( const f32x4 a = v0 * sc, b = v1 * sc; u32x2 w; w.x = pack_fp8x4(a[0], a[1], a[2], a[3]); w.y = pack_fp8x4(b[0], b[1], b[2], b[3]);
                *(u32x2*)((unsigned char*)(P + (size_t)row * NCOL) + col) = w; )
        } else {
            const float sc = ((pn == 6 || pn == 7) ? SB_QSCALE : 1.0f) * ws;
            EPI_ROWS( *(u32x4*)(P + (size_t)row * NCOL + col) = pack8(v0 * sc, v1 * sc); )
        }
    }
};
struct EpiMergeA {
    const bf16_t* P; bf16_t* T;
    DI void init(f32x4 (&acc)[2][2][4][2], const pg8::Unit&, int, int) const {
#pragma unroll
        for (int a = 0; a < 2; ++a)
#pragma unroll
            for (int b = 0; b < 2; ++b)
#pragma unroll
                for (int m = 0; m < 4; ++m)
#pragma unroll
                    for (int n = 0; n < 2; ++n) acc[a][b][m][n] = (f32x4){0.f, 0.f, 0.f, 0.f};
    }
    DI void operator()(const f32x4 (&acc)[2][2][4][2], const pg8::Unit& u, int wr, int wc, int fr, int fq) const {
        EPI_ROWS( f32x4 ga, gb; unpack8_fp8(*(const u32x2*)gate8_ptr(P, row, col), ga, gb);
            const f32x4 t0 = v0 * ga * (T_SCALE / (WFA_SCALE * OLAT_SCALE * GATE_SCALE)), t1 = v1 * gb * (T_SCALE / (WFA_SCALE * OLAT_SCALE * GATE_SCALE));
            u32x2 w; w.x = pack_fp8x4(t0[0], t0[1], t0[2], t0[3]); w.y = pack_fp8x4(t1[0], t1[1], t1[2], t1[3]);
            *(u32x2*)((unsigned char*)T + (size_t)row * DM + col) = w; )
    }
};
struct EpiMergeB {
    const bf16_t* P; const bf16_t* T; unsigned char* MG;
    DI void init(f32x4 (&acc)[2][2][4][2], const pg8::Unit&, int, int) const {
#pragma unroll
        for (int a = 0; a < 2; ++a)
#pragma unroll
            for (int b = 0; b < 2; ++b)
#pragma unroll
                for (int m = 0; m < 4; ++m)
#pragma unroll
                    for (int n = 0; n < 2; ++n) acc[a][b][m][n] = (f32x4){0.f, 0.f, 0.f, 0.f};
    }
    DI void operator()(const f32x4 (&acc)[2][2][4][2], const pg8::Unit& u, int wr, int wc, int fr, int fq) const {
        EPI_ROWS( f32x4 ga, gb, ta, tb; unpack8_fp8(*(const u32x2*)gate8_ptr(P, row, 1024 + col), ga, gb); unpack8_fp8(*(const u32x2*)((const unsigned char*)T + (size_t)row * DM + col), ta, tb);
            const f32x4 m0 = (ta * (1.0f / T_SCALE) + v0 * ga * (1.0f / (WB_SCALE * OB_SCALE * GATE_SCALE))) * MG_SCALE, m1 = (tb * (1.0f / T_SCALE) + v1 * gb * (1.0f / (WB_SCALE * OB_SCALE * GATE_SCALE))) * MG_SCALE;
            u32x2 w; w.x = pack_fp8x4(m0[0], m0[1], m0[2], m0[3]); w.y = pack_fp8x4(m1[0], m1[1], m1[2], m1[3]);
            *(u32x2*)(MG + (size_t)row * DM + col) = w; )
    }
};
struct EpiWo {
    const void* X; const float* gate; bf16_t* Z; bool xbf;
    DI void init(f32x4 (&acc)[2][2][4][2], const pg8::Unit&, int, int) const {
#pragma unroll
        for (int a = 0; a < 2; ++a)
#pragma unroll
            for (int b = 0; b < 2; ++b)
#pragma unroll
                for (int m = 0; m < 4; ++m)
#pragma unroll
                    for (int n = 0; n < 2; ++n) acc[a][b][m][n] = (f32x4){0.f, 0.f, 0.f, 0.f};
    }
    DI void operator()(const f32x4 (&acc)[2][2][4][2], const pg8::Unit& u, int wr, int wc, int fr, int fq) const {
        f32x4 gq[2][2];
#pragma unroll
        for (int bj = 0; bj < 2; ++bj) { const float* g = gate + (size_t)((u.pm * 256) / SEQ) * 6144 + u.pn * 256 + bj * 128 + wc * 32 + 8 * fq; gq[bj][0] = *(const f32x4*)g; gq[bj][1] = *(const f32x4*)(g + 4); }
        EPI_ROWS( const f32x4 g0 = gq[bj][0], g1 = gq[bj][1]; f32x4 x0, x1;
            if (xbf) { const u32x4 xw = __builtin_nontemporal_load((const u32x4*)((const bf16_t*)X + (size_t)row * DM + col)); x0 = (f32x4){bf_lo(xw.x), bf_hi(xw.x), bf_lo(xw.y), bf_hi(xw.y)}; x1 = (f32x4){bf_lo(xw.z), bf_hi(xw.z), bf_lo(xw.w), bf_hi(xw.w)}; }
            else { const float* xp = (const float*)X + (size_t)row * DM + col; x0 = __builtin_nontemporal_load((const f32x4*)xp); x1 = __builtin_nontemporal_load((const f32x4*)(xp + 4)); }
            const f32x4 z0 = x0 * DN_ALPHA + g0 * v0 * (1.0f / (WO_SCALE * MG_SCALE)), z1 = x1 * DN_ALPHA + g1 * v1 * (1.0f / (WO_SCALE * MG_SCALE));
            *(u32x4*)(Z + (size_t)row * DM + col) = (u32x4){cvt_pk_bf16(z0.x, z0.y), cvt_pk_bf16(z0.z, z0.w), cvt_pk_bf16(z1.x, z1.y), cvt_pk_bf16(z1.z, z1.w)}; )
    }
};
struct EpiGateUp {
    const float* b_gu; unsigned char* ACT;
    DI void init(f32x4 (&acc)[2][2][4][2], const pg8::Unit& u, int wc, int fq) const {
        const int hc = u.pn * 128 + wc * 32 + 8 * fq;
        const float* ba = b_gu + (size_t)u.aux * 2048 + hc; const float* bu = ba + 1024;
        const f32x4 ba0 = *(const f32x4*)ba * WGU_SCALE, ba1 = *(const f32x4*)(ba + 4) * WGU_SCALE, bu0 = *(const f32x4*)bu * WGU_SCALE, bu1 = *(const f32x4*)(bu + 4) * WGU_SCALE;
#pragma unroll
        for (int a = 0; a < 2; ++a)
#pragma unroll
            for (int m = 0; m < 4; ++m) { acc[a][0][m][0] = ba0; acc[a][0][m][1] = ba1; acc[a][1][m][0] = bu0; acc[a][1][m][1] = bu1; }
    }
    DI void operator()(const f32x4 (&acc)[2][2][4][2], const pg8::Unit& u, int wr, int wc, int fr, int fq) const {
        const int hc = u.pn * 128 + wc * 32 + 8 * fq;
        constexpr float inv = 1.0f / WGU_SCALE;
#pragma unroll
        for (int ai = 0; ai < 2; ++ai)
#pragma unroll
            for (int m = 0; m < 4; ++m) { const int row = u.pm * 256 + ai * 128 + wr * 64 + m * 16 + fr;
                f32x4 r0, r1;
#pragma unroll
                for (int q = 0; q < 4; ++q) {
                    float a = fminf(acc[ai][0][m][0][q] * inv, 7.0f), uu = fminf(fmaxf(acc[ai][1][m][0][q] * inv, -7.0f), 7.0f);
                    r0[q] = (uu + 1.0f) * a * sigmoidf_(1.702f * a);
                    a = fminf(acc[ai][0][m][1][q] * inv, 7.0f); uu = fminf(fmaxf(acc[ai][1][m][1][q] * inv, -7.0f), 7.0f);
                    r1[q] = (uu + 1.0f) * a * sigmoidf_(1.702f * a); }
                u32x2 w; w.x = pack_fp8x4(r0[0], r0[1], r0[2], r0[3]); w.y = pack_fp8x4(r1[0], r1[1], r1[2], r1[3]);
                *(u32x2*)(ACT + (size_t)row * DEXP + hc) = w; }
    }
};
struct EpiDown {
    const float* b_dn; const unsigned* list; const float* gate; bf16_t* YS; const LAS int* tstart; const LAS int* cnt;
    DI void init(f32x4 (&acc)[2][2][4][2], const pg8::Unit& u, int wc, int fq) const {
#pragma unroll
        for (int bj = 0; bj < 2; ++bj) { const float* bp = b_dn + (size_t)u.aux * DM + u.pn * 256 + bj * 128 + wc * 32 + 8 * fq; const f32x4 b0 = *(const f32x4*)bp * WDN_SCALE, b1 = *(const f32x4*)(bp + 4) * WDN_SCALE;
#pragma unroll
            for (int a = 0; a < 2; ++a)
#pragma unroll
                for (int m = 0; m < 4; ++m) { acc[a][bj][m][0] = b0; acc[a][bj][m][1] = b1; } }
    }
    DI void operator()(const f32x4 (&acc)[2][2][4][2], const pg8::Unit& u, int wr, int wc, int fr, int fq) const {
        const int e = u.aux, lbase = (u.pm - tstart[e]) * 256, n = cnt[e];
        unsigned ent[8]; float g[8];
        const unsigned* lp = list + (size_t)e * NTOK; const float* gp = gate + (size_t)e * NTOK;
#pragma unroll
        for (int ai = 0; ai < 2; ++ai)
#pragma unroll
            for (int m = 0; m < 4; ++m) { int lr = lbase + ai * 128 + wr * 64 + m * 16 + fr; lr = lr < n ? lr : n - 1; ent[ai * 4 + m] = lp[lr]; g[ai * 4 + m] = gp[lr]; }
#pragma unroll
        for (int ai = 0; ai < 2; ++ai)
#pragma unroll
            for (int m = 0; m < 4; ++m) { const int lr = lbase + ai * 128 + wr * 64 + m * 16 + fr;
                if (lr < n) { const unsigned en = ent[ai * 4 + m]; const float gg = g[ai * 4 + m] * (1.0f / WDN_SCALE);
#pragma unroll
                    for (int bj = 0; bj < 2; ++bj) { const int col = u.pn * 256 + bj * 128 + wc * 32 + 8 * fq;
                        *(u32x4*)(YS + (size_t)en * DM + col) = pack8(acc[ai][bj][m][0] * gg, acc[ai][bj][m][1] * gg); } } }
    }
};

DI void phase_lnmod0(Ctx& F) {
    const int gw = F.vcu * 8 + F.wave, NGW = F.G * 8;
    const float* mod = (const float*)(F.ws + WS_MOD);
    unsigned char* H = (unsigned char*)(F.ws + WS_H);
    f32x4 vn[4];
    f32x4 SH[4], SC[4]; int bcur = -1;
    if (gw < NTOK) load_row(F.x + (size_t)gw * DM, F.lane, vn);
    for (int m = gw; m < NTOK; m += NGW) {
        f32x4 v[4];
#pragma unroll
        for (int j = 0; j < 4; ++j) v[j] = vn[j];
        if (m + NGW < NTOK) load_row(F.x + (size_t)(m + NGW) * DM, F.lane, vn);
        const int b = m / SEQ;
        if (b != bcur) { bcur = b; const float* mb = mod + (size_t)b * 6144;
#pragma unroll
            for (int j = 0; j < 4; ++j) { SH[j] = *((const GAS f32x4*)mb + F.lane + 64 * j); SC[j] = *((const GAS f32x4*)(mb + DM) + F.lane + 64 * j); } }
        float mean, rstd; ln_stats(v, mean, rstd);
#pragma unroll
        for (int j = 0; j < 4; ++j) { const f32x4 o = (v[j] - mean) * rstd * (SC[j] + 1.0f) + SH[j];
            *((GAS unsigned*)(H + (size_t)m * DM) + F.lane + 64 * j) = pack_fp8x4(o.x, o.y, o.z, o.w); }
    }
}
DI void phase_misc(Ctx& F, int l) {
    const int gw = F.vcu * 8 + F.wave, NGW = F.G * 8;
    const float* MISC = (const float*)(F.ws + WS_MISC);
    bf16_t* CKV = (bf16_t*)(F.ws + WS_CKV); bf16_t* KIDX = (bf16_t*)(F.ws + WS_KIDX); float* WIDX = (float*)(F.ws + WS_WIDX);
    const float idx_scale = 0.5f * 0.125f;
    const int g = F.lane >> 4, i = F.lane & 15;
    f32x4 gk[4];
#pragma unroll
    for (int k = 0; k < 4; ++k) gk[k] = (i < 8) ? *((const GAS f32x4*)(F.g_kv + (size_t)l * KVR + 16 * i) + k) : (f32x4){0.f, 0.f, 0.f, 0.f};
    f32x4 vn[4];
    if (gw * 4 < NTOK) {
#pragma unroll
        for (int k = 0; k < 4; ++k) vn[k] = __builtin_nontemporal_load((const GAS f32x4*)(MISC + (size_t)(gw * 4 + g) * 256 + 16 * i) + k);
    }
    for (int m0 = gw * 4; m0 < NTOK; m0 += NGW * 4) {
        const int m = m0 + g;
        f32x4 v[4];
#pragma unroll
        for (int k = 0; k < 4; ++k) v[k] = vn[k];
        if (m0 + NGW * 4 < NTOK) {
#pragma unroll
            for (int k = 0; k < 4; ++k) vn[k] = __builtin_nontemporal_load((const GAS f32x4*)(MISC + (size_t)(m + NGW * 4) * 256 + 16 * i) + k);
        }
        float s = 0.f;
#pragma unroll
        for (int k = 0; k < 4; ++k) s += (v[k].x * v[k].x + v[k].y * v[k].y) + (v[k].z * v[k].z + v[k].w * v[k].w);
        s += DPPF(s, 0xB1); s += DPPF(s, 0x4E); s += DPPF(s, 0x141);
        const float r = 1.0f / sqrtf(s * (1.f / KVR) + RMS_EPS);
        if (i < 8) { u32x4 w;
            const f32x4 e0 = v[0] * r * gk[0], e1 = v[1] * r * gk[1], e2 = v[2] * r * gk[2], e3 = v[3] * r * gk[3];
            w.x = pack_fp8x4(e0.x, e0.y, e0.z, e0.w); w.y = pack_fp8x4(e1.x, e1.y, e1.z, e1.w); w.z = pack_fp8x4(e2.x, e2.y, e2.z, e2.w); w.w = pack_fp8x4(e3.x, e3.y, e3.z, e3.w);
            *(GAS u32x4*)((unsigned char*)CKV + (size_t)m * KVR + 16 * i) = w; }
        else if (i < 12) { u32x4 w0, w1;
            w0.x = cvt_pk_bf16(v[0].x, v[0].y); w0.y = cvt_pk_bf16(v[0].z, v[0].w); w0.z = cvt_pk_bf16(v[1].x, v[1].y); w0.w = cvt_pk_bf16(v[1].z, v[1].w);
            w1.x = cvt_pk_bf16(v[2].x, v[2].y); w1.y = cvt_pk_bf16(v[2].z, v[2].w); w1.z = cvt_pk_bf16(v[3].x, v[3].y); w1.w = cvt_pk_bf16(v[3].z, v[3].w);
            GAS u32x4* o = (GAS u32x4*)(KIDX + (size_t)m * IDXD + 16 * (i - 8)); o[0] = w0; o[1] = w1; }
        else if (i == 12) { *((GAS f32x4*)(WIDX + (size_t)m * 4)) = v[0] * idx_scale; }
    }
}

DI void phase_ln_router(Ctx& F, int l) {
    const float* mod = (const float*)(F.ws + WS_MOD) + (size_t)l * 8 * 6144;
    const bf16_t* ZB = (const bf16_t*)(F.ws + WS_ZX); bf16_t* H = (bf16_t*)(F.ws + WS_H);
    const float* g1 = F.ln1_g + (size_t)l * DM; const float* b1 = F.ln1_b + (size_t)l * DM;
    const float* wr = F.w_router + (size_t)l * DM * NEXP; const float* br = F.b_router + (size_t)l * NEXP;
    LAS float* tile = (LAS float*)F.lds;
    LAS float* part = (LAS float*)F.lds;
    LAS float* logit = (LAS float*)(F.lds + 135168);
    LAS unsigned* rec_e = (LAS unsigned*)(F.lds + 140288);
    LAS float* rec_g = (LAS float*)(F.lds + 140288 + 8192);
    LAS unsigned* lcnt = (LAS unsigned*)(F.lds + 140288 + 16384);
    unsigned* list = (unsigned*)(F.ws + WS_LIST); float* gate = (float*)(F.ws + WS_GATEL);
    const int lane = F.lane, w = F.wave, hi = lane >> 5, r32 = lane & 31;
    const float* wrl = wr + (size_t)(128 * w + 4 * hi) * NEXP + r32;
    if (F.tid < 32) lcnt[F.tid] = 0u;
    __syncthreads();
    const int ntile = NTOK / 32; int nloc = 0;
    float bw[64];
#pragma unroll
    for (int s = 0; s < 64; ++s) bw[s] = wrl[(8 * (s >> 2) + (s & 3)) * NEXP];
    u32x2 nraw[4][4];
    if (F.vcu < ntile) {
#pragma unroll
        for (int rr = 0; rr < 4; ++rr)
#pragma unroll
            for (int j = 0; j < 4; ++j) nraw[rr][j] = *((const GAS u32x2*)(ZB + (size_t)(F.vcu * 32 + 4 * w + rr) * DM) + lane + 64 * j);
    }
    for (int tI = F.vcu; tI < ntile; tI += F.G, ++nloc) {
        const int tok0 = tI * 32;
        f32x4 vr[4][4];
#pragma unroll
        for (int rr = 0; rr < 4; ++rr)
#pragma unroll
            for (int j = 0; j < 4; ++j) { const u32x2 w_ = nraw[rr][j]; vr[rr][j] = (f32x4){bf_lo(w_.x), bf_hi(w_.x), bf_lo(w_.y), bf_hi(w_.y)}; }
#pragma unroll
        for (int rr = 0; rr < 4; ++rr) {
            const int row = tok0 + 4 * w + rr; const int b = row / SEQ;
            f32x4 (&v)[4] = vr[rr];
            float mean, rstd; ln_stats(v, mean, rstd);
#pragma unroll
            for (int j = 0; j < 4; ++j) { const f32x4 gg = *((const GAS f32x4*)g1 + lane + 64 * j), bb = *((const GAS f32x4*)b1 + lane + 64 * j);
                v[j] = (v[j] - mean) * rstd * gg + bb; }
            ln_stats(v, mean, rstd);
            const float* sh = mod + (size_t)b * 6144 + 3 * DM; const float* sc = sh + DM;
#pragma unroll
            for (int j = 0; j < 4; ++j) { const f32x4 s4 = *((const GAS f32x4*)sh + lane + 64 * j), c4 = *((const GAS f32x4*)sc + lane + 64 * j);
                const f32x4 o = (v[j] - mean) * rstd * (c4 + 1.0f) + s4;
                *((GAS unsigned*)((unsigned char*)H + (size_t)row * DM) + lane + 64 * j) = pack_fp8x4(o.x, o.y, o.z, o.w);
                *(LAS f32x4*)(tile + (4 * w + rr) * 1028 + 4 * lane + 256 * j) = o; }
        }
        __syncthreads();
        f32x16 acc;
#pragma unroll
        for (int i = 0; i < 16; ++i) acc[i] = 0.f;
#pragma unroll
        for (int s4 = 0; s4 < 16; ++s4) {
            const f32x4 a4 = *(const LAS f32x4*)(tile + r32 * 1028 + 128 * w + 8 * s4 + 4 * hi);
#pragma unroll
            for (int q = 0; q < 4; ++q) acc = __builtin_amdgcn_mfma_f32_32x32x2f32(a4[q], bw[4 * s4 + q], acc, 0, 0, 0);
        }
        __syncthreads();
#pragma unroll
        for (int i = 0; i < 16; ++i) part[(w * 32 + ((i & 3) + 8 * (i >> 2) + 4 * hi)) * 33 + r32] = acc[i];
        if (tI + F.G < ntile) {
#pragma unroll
            for (int rr = 0; rr < 4; ++rr)
#pragma unroll
                for (int j = 0; j < 4; ++j) nraw[rr][j] = *((const GAS u32x2*)(ZB + (size_t)((tI + F.G) * 32 + 4 * w + rr) * DM) + lane + 64 * j);
        }
        __syncthreads();
        for (int u = F.tid; u < 1024; u += 512) { const int t = u >> 5, e = u & 31; float s = br[e];
#pragma unroll
            for (int k = 0; k < 8; ++k) s += part[(k * 32 + t) * 33 + e];
            logit[t * 33 + e] = s; }
        __syncthreads();
        {
            int td_ = F.tid; asm volatile("" : "+v"(td_));
            const int t = td_ >> 4, j = td_ & 15;
            float v0 = logit[t * 33 + j], v1 = logit[t * 33 + 16 + j];
            float tv[4]; int te[4];
#pragma unroll
            for (int k = 0; k < 4; ++k) {
                const bool first = (v0 >= v1);
                const float lv = first ? v0 : v1; const int li = first ? j : j + 16;
                float m = lv;
                m = fmaxf(m, DPPF(m, 0xB1)); m = fmaxf(m, DPPF(m, 0x4E)); m = fmaxf(m, DPPF(m, 0x141)); m = fmaxf(m, DPPF(m, 0x140));
                int ci = (lv == m) ? li : 99;
                { int o_; o_ = __builtin_amdgcn_update_dpp(0, ci, 0xB1, 0xf, 0xf, false); ci = ci < o_ ? ci : o_; o_ = __builtin_amdgcn_update_dpp(0, ci, 0x4E, 0xf, 0xf, false); ci = ci < o_ ? ci : o_;
                  o_ = __builtin_amdgcn_update_dpp(0, ci, 0x141, 0xf, 0xf, false); ci = ci < o_ ? ci : o_; o_ = __builtin_amdgcn_update_dpp(0, ci, 0x140, 0xf, 0xf, false); ci = ci < o_ ? ci : o_; }
                tv[k] = m; te[k] = ci;
                if (ci == j) v0 = -INFINITY; if (ci == j + 16) v1 = -INFINITY;
            }
            const float e1 = __expf(tv[1] - tv[0]), e2 = __expf(tv[2] - tv[0]), e3 = __expf(tv[3] - tv[0]); const float inv = 1.0f / (1.0f + e1 + e2 + e3);
            if (j < 4) { const int ek = (j == 0) ? te[0] : (j == 1) ? te[1] : (j == 2) ? te[2] : te[3]; const float gk = ((j == 0) ? 1.0f : (j == 1) ? e1 : (j == 2) ? e2 : e3) * inv;
                const unsigned lr = atomicAdd((unsigned*)&lcnt[ek], 1u); rec_e[(nloc * 32 + t) * 4 + j] = (unsigned)ek | (lr << 8); rec_g[(nloc * 32 + t) * 4 + j] = gk; }
        }
        __syncthreads();
    }
    if (F.tid < 32) lcnt[32 + F.tid] = __hip_atomic_fetch_add((unsigned*)(F.ctl + CW_CNT + l * NEXP + F.tid), lcnt[F.tid], RLX_AGENT);
    __syncthreads();
    for (int u = F.tid; u < nloc * 128; u += 512) {
        const int tl = u >> 2, k = u & 3; const int tok = (F.vcu + (tl >> 5) * F.G) * 32 + (tl & 31);
        const unsigned re = rec_e[u]; const unsigned e = re & 255u, lr = re >> 8;
        list[(size_t)e * NTOK + lcnt[32 + e] + lr] = (unsigned)tok * 4u + (unsigned)k;
        gate[(size_t)e * NTOK + lcnt[32 + e] + lr] = rec_g[u];
    }
    __syncthreads();
}

DI void phase_final(Ctx& F, int l, float* xout, bool has_next) {
    const int gw = F.vcu * 8 + F.wave, NGW = F.G * 8;
    const float* mod = (const float*)(F.ws + WS_MOD) + (size_t)l * 8 * 6144;
    const float* modn = (const float*)(F.ws + WS_MOD) + (size_t)(l + 1) * 8 * 6144;
    const bf16_t* ZB = (const bf16_t*)(F.ws + WS_ZX); bf16_t* XB = (bf16_t*)(F.ws + WS_XB); const bf16_t* YS = (const bf16_t*)(F.ws + WS_YS); unsigned char* H = (unsigned char*)(F.ws + WS_H);
    const float* g1 = F.ln1_g + (size_t)l * DM; const float* b1 = F.ln1_b + (size_t)l * DM;
    const float* g2 = F.ln2_g + (size_t)l * DM; const float* b2 = F.ln2_b + (size_t)l * DM;
    u32x2 zn[4], yn[4][4];
#define FIN_LOAD(M) do { _Pragma("unroll") for (int j = 0; j < 4; ++j) { zn[j] = __builtin_nontemporal_load((const GAS u32x2*)(ZB + (size_t)(M) * DM) + F.lane + 64 * j); \
        _Pragma("unroll") for (int k = 0; k < 4; ++k) yn[j][k] = __builtin_nontemporal_load((const GAS u32x2*)(YS + ((size_t)(M) * 4 + k) * DM) + F.lane + 64 * j); } } while (0)
    if (gw < NTOK) FIN_LOAD(gw);
    f32x4 G1[4], B1[4], G2[4], B2[4];
#pragma unroll
    for (int j = 0; j < 4; ++j) { G1[j] = *((const GAS f32x4*)g1 + F.lane + 64 * j); B1[j] = *((const GAS f32x4*)b1 + F.lane + 64 * j); G2[j] = *((const GAS f32x4*)g2 + F.lane + 64 * j); B2[j] = *((const GAS f32x4*)b2 + F.lane + 64 * j); }
    f32x4 GT[4], SH[4], SC[4]; int bcur = -1;
    for (int m = gw; m < NTOK; m += NGW) {
        const int b = m / SEQ; f32x4 v[4], y[4];
        if (b != bcur) { bcur = b; const float* gt_ = mod + (size_t)b * 6144 + 5 * DM; const float* mb_ = modn + (size_t)b * 6144;
#pragma unroll
            for (int j = 0; j < 4; ++j) { GT[j] = *((const GAS f32x4*)gt_ + F.lane + 64 * j);
                if (has_next) { SH[j] = *((const GAS f32x4*)mb_ + F.lane + 64 * j); SC[j] = *((const GAS f32x4*)(mb_ + DM) + F.lane + 64 * j); } else { SH[j] = GT[j]; SC[j] = GT[j]; } } }
#pragma unroll
        for (int j = 0; j < 4; ++j) { v[j] = (f32x4){bf_lo(zn[j].x), bf_hi(zn[j].x), bf_lo(zn[j].y), bf_hi(zn[j].y)}; y[j] = (f32x4){0.f, 0.f, 0.f, 0.f};
#pragma unroll
            for (int k = 0; k < 4; ++k) { const u32x2 w = yn[j][k]; y[j] += (f32x4){bf_lo(w.x), bf_hi(w.x), bf_lo(w.y), bf_hi(w.y)}; } }
        if (m + NGW < NTOK) FIN_LOAD(m + NGW);
        float mean, rstd; ln_stats(v, mean, rstd);
#pragma unroll
        for (int j = 0; j < 4; ++j) v[j] = ((v[j] - mean) * rstd * G1[j] + B1[j]) * DN_ALPHA + GT[j] * y[j];
        ln_stats(v, mean, rstd);
#pragma unroll
        for (int j = 0; j < 4; ++j) {
            v[j] = (v[j] - mean) * rstd * G2[j] + B2[j];
            if (has_next) __builtin_nontemporal_store((u32x2){cvt_pk_bf16(v[j].x, v[j].y), cvt_pk_bf16(v[j].z, v[j].w)}, (GAS u32x2*)(XB + (size_t)m * DM) + F.lane + 64 * j);
            else *((GAS f32x4*)(xout + (size_t)m * DM) + F.lane + 64 * j) = v[j]; }
        if (has_next) {
            ln_stats(v, mean, rstd);
#pragma unroll
            for (int j = 0; j < 4; ++j) { const f32x4 o = (v[j] - mean) * rstd * (SC[j] + 1.0f) + SH[j];
                *((GAS unsigned*)(H + (size_t)m * DM) + F.lane + 64 * j) = pack_fp8x4(o.x, o.y, o.z, o.w); } }
    }
#undef FIN_LOAD
}

typedef LAS const char* lds_cptr;
typedef short v4i16_t __attribute__((ext_vector_type(4)));
typedef int v2i_t __attribute__((ext_vector_type(2)));
DI s16x4 vtr(lds_cptr p) { return __builtin_bit_cast(s16x4, __builtin_amdgcn_ds_read_tr16_b64_v4i16((LAS v4i16_t*)p)); }
DI int crow(int r, int hi) { return (r & 3) + 8 * (r >> 2) + 4 * hi; }
DI float pair_sum(float v) { auto rr = __builtin_amdgcn_permlane32_swap(__float_as_uint(v), __float_as_uint(v), false, false); return __uint_as_float(rr[0]) + __uint_as_float(rr[1]); }

DI void sb_unit(Ctx& F, int u) {
    const bf16_t* P = (const bf16_t*)(F.ws + WS_P); bf16_t* OB = (bf16_t*)(F.ws + WS_OB);
    int lane_ = F.lane; asm volatile("" : "+v"(lane_));
    const int lane = lane_, r32 = lane & 31, hi = lane >> 5;
    LAS char* vs = (LAS char*)(F.lds + F.wave * 8192);
    const lds_cptr vp0 = (lds_cptr)vs + ((lane >> 4) & 1) * 32 + (lane & 3) * 8 + (4 * hi + ((lane & 15) >> 2)) * 64;
    {
        const int qblk = u & 255, h = (u >> 8) & 7, b = u >> 11, t0 = qblk * 32, t = t0 + r32;
        const size_t rowb = (size_t)b * SEQ;
        bf16x8 qr[4];
        { const bf16_t* Qp = P + (rowb + t) * NCOL + PC_QB + h * 64 + hi * 8;
#pragma unroll
          for (int d0 = 0; d0 < 4; ++d0) qr[d0] = *(const bf16x8*)(Qp + d0 * 16); }
        f32x16 o[2];
#pragma unroll
        for (int i = 0; i < 16; ++i) { o[0][i] = 0.f; o[1][i] = 0.f; }
        float carry = 0.f;
        bf16x8 kn0[4], kn1[4];
        { const bf16_t* Kp = P + (rowb + 64 * (t0 >> 6) + r32) * NCOL + PC_KB + h * 64 + hi * 8;
#pragma unroll
          for (int d0 = 0; d0 < 4; ++d0) { kn0[d0] = *(const bf16x8*)(Kp + d0 * 16); kn1[d0] = *(const bf16x8*)(Kp + (size_t)32 * NCOL + d0 * 16); } }
        for (int j = t0 >> 6; j >= 0; --j) {
            bf16x8 k0[4], k1[4];
#pragma unroll
            for (int d0 = 0; d0 < 4; ++d0) { k0[d0] = kn0[d0]; k1[d0] = kn1[d0]; }
            LDS_WAIT();
#pragma unroll
            for (int i = 0; i < 8; ++i) { const int row = 16 * (i & 3) + (lane >> 2), col = (i >> 2) * 32 + (lane & 3) * 8;
                __builtin_amdgcn_global_load_lds((const unsigned*)(P + (rowb + 64 * j + row) * NCOL + PC_VB + h * 64 + col), (LAS unsigned*)(vs + i * 1024), 16, 0, 0); }
            if (j > 0) { const bf16_t* Kp = P + (rowb + 64 * (j - 1) + r32) * NCOL + PC_KB + h * 64 + hi * 8;
#pragma unroll
                for (int d0 = 0; d0 < 4; ++d0) { kn0[d0] = *(const bf16x8*)(Kp + d0 * 16); kn1[d0] = *(const bf16x8*)(Kp + (size_t)32 * NCOL + d0 * 16); } }
            f32x16 p0, p1;
#pragma unroll
            for (int i = 0; i < 16; ++i) { p0[i] = 0.f; p1[i] = 0.f; }
#pragma unroll
            for (int d0 = 0; d0 < 4; ++d0) { p0 = __builtin_amdgcn_mfma_f32_32x32x16_bf16(k0[d0], qr[d0], p0, 0, 0, 0); p1 = __builtin_amdgcn_mfma_f32_32x32x16_bf16(k1[d0], qr[d0], p1, 0, 0, 0); }
            const bool diag = (64 * j + 63 >= t0);
            float L0[16], L1[16];
#pragma unroll
            for (int r = 0; r < 16; ++r) {
                const int s0 = 64 * j + crow(r, hi);
                float a = fmaxf(p0[r], 0.f) + fast_log2(1.0f + fast_exp2(-fabsf(p0[r])));
                float c = fmaxf(p1[r], 0.f) + fast_log2(1.0f + fast_exp2(-fabsf(p1[r])));
                if (diag) { if (s0 >= t) a = 0.f; if (s0 + 32 >= t) c = 0.f; }
                L0[r] = a; L1[r] = c; }
            float W[8], T[8];
#pragma unroll
            for (int g = 0; g < 4; ++g) { T[g] = (L0[4 * g] + L0[4 * g + 1]) + (L0[4 * g + 2] + L0[4 * g + 3]); T[4 + g] = (L1[4 * g] + L1[4 * g + 1]) + (L1[4 * g + 2] + L1[4 * g + 3]); }
#pragma unroll
            for (int g = 0; g < 8; ++g) W[g] = pair_sum(T[g]);
            float suf = carry;
#pragma unroll
            for (int g = 7; g >= 0; --g) {
                float off = suf + ((hi == 0) ? (W[g] - T[g]) : 0.f);
                if (g >= 4) {
#pragma unroll
                    for (int q = 3; q >= 0; --q) { const int r = 4 * (g - 4) + q; off += L1[r]; float a = fast_exp2(p1[r] - off); if (diag && (64 * j + 32 + crow(r, hi) >= t)) a = 0.f; p1[r] = a; }
                } else {
#pragma unroll
                    for (int q = 3; q >= 0; --q) { const int r = 4 * g + q; off += L0[r]; float a = fast_exp2(p0[r] - off); if (diag && (64 * j + crow(r, hi) >= t)) a = 0.f; p0[r] = a; }
                }
                suf += W[g];
            }
            carry = suf;
            asm volatile("s_waitcnt vmcnt(0)" ::: "memory");
            u32x4 pw[4];
#pragma unroll
            for (int q = 0; q < 4; ++q) { pw[0][q] = cvt_pk_bf16(p0[2 * q], p0[2 * q + 1]); pw[1][q] = cvt_pk_bf16(p0[8 + 2 * q], p0[8 + 2 * q + 1]); pw[2][q] = cvt_pk_bf16(p1[2 * q], p1[2 * q + 1]); pw[3][q] = cvt_pk_bf16(p1[8 + 2 * q], p1[8 + 2 * q + 1]); }
#pragma unroll
            for (int d0 = 0; d0 < 2; ++d0)
#pragma unroll
                for (int ks = 0; ks < 4; ++ks) {
                    const s16x4 lo = vtr(vp0 + d0 * 4096 + ks * 1024), hv = vtr(vp0 + d0 * 4096 + ks * 1024 + 512);
                    const bf16x8 vf = (bf16x8){lo[0], lo[1], lo[2], lo[3], hv[0], hv[1], hv[2], hv[3]};
                    o[d0] = __builtin_amdgcn_mfma_f32_32x32x16_bf16(__builtin_bit_cast(bf16x8, pw[ks]), vf, o[d0], 0, 0, 0); }
            if (!__any(carry < SB_STOP)) break;
        }
        unsigned char* Op = (unsigned char*)OB + (rowb + t0) * 512 + h * 64 + r32;
#pragma unroll
        for (int i = 0; i < 16; ++i) { const int row = crow(i, hi); const unsigned pk = pack_fp8x4(o[0][i] * OB_SCALE, o[1][i] * OB_SCALE, 0.f, 0.f);
            Op[(size_t)row * 512] = (unsigned char)(pk & 0xffu); Op[(size_t)row * 512 + 32] = (unsigned char)((pk >> 8) & 0xffu); }
    }
    LDS_WAIT();
}

constexpr int DS_HIST = 0;
constexpr int DS_STAGE = 0;
constexpr int CAND_CAP = 512;
constexpr int SAMPLE_STRIDE = 4;
constexpr int DS_CKEY = 0;
constexpr int DS_CIDX = 65536;
constexpr int DS_BMAP = 98304;
constexpr int DS_SEL = 131200;
constexpr int DS_SELCNT = DS_SEL + 16384;
constexpr int DS_STATE = DS_SELCNT + 128;
constexpr int DS_CSUM = DS_STATE + 8 * 128;
constexpr int DS_LUT = DS_CSUM + 2048;
constexpr int DS_WH = DS_LUT + 129 * 8 * 4;
constexpr int DS_END = DS_WH + 8 * 512;
static_assert(DS_END <= SCH_OFF, "DSA LDS map");
constexpr int STG_ROW = 272, STG_WAVE = 32 * STG_ROW;
static_assert(8 * STG_WAVE <= DS_BMAP && DS_BMAP + 32768 <= DS_SEL && DS_CIDX + 32 * CAND_CAP * 2 <= DS_BMAP, "overlay placement");
constexpr unsigned BIN_LO = 114u << 23, BIN_HI = BIN_LO + (16u << 23) - 1u;

DI unsigned f2key(float f) { const unsigned u = __float_as_uint(f + 0.0f); return u ^ ((unsigned)((int)u >> 31) | 0x80000000u); }

struct DsaQ {
    bf16x8 qf[4][4];
    float w[4];
};

DI unsigned bin11(unsigned key) {
    const bool pos = (key >> 31) != 0u;
    const unsigned mag = pos ? (key & 0x7fffffffu) : (~key & 0x7fffffffu);
    const unsigned mc = mag < BIN_LO ? BIN_LO : (mag > BIN_HI ? BIN_HI : mag);
    const unsigned mb = (mc - BIN_LO) >> 17;
    return pos ? 1024u + mb : 1023u - mb;
}
DI unsigned bin11_lokey(unsigned b) {
    if (b >= 1024u) { const unsigned mb = b - 1024u; return 0x80000000u | (mb == 0u ? 0u : BIN_LO + (mb << 17)); }
    const unsigned mb = 1023u - b; const unsigned mh = (mb == 1023u) ? 0x7fffffffu : BIN_LO + (mb << 17) + 0x1ffffu;
    return (~mh) & 0x7fffffffu;
}
template <int MODE, bool DIAG>
DI void dsa_pass_impl(Ctx& F, const DsaQ& Q, const bf16_t* KIDX, size_t rowb, int qb, int kstart, int kstep, unsigned pre, unsigned tieB, unsigned tieR, unsigned need) {
    int lane_ = F.lane; asm volatile("" : "+v"(lane_));
    const int lane = lane_, r32 = lane & 31, hi = lane >> 5;
    LAS unsigned* hist = (LAS unsigned*)(F.lds + DS_HIST) + r32 * 1025;
    LAS unsigned* bmap = (LAS unsigned*)(F.lds + DS_BMAP) + r32 * 256;
    LAS unsigned* ckey = (LAS unsigned*)(F.lds + DS_CKEY) + r32 * CAND_CAP;
    LAS unsigned short* cidx = (LAS unsigned short*)(F.lds + DS_CIDX) + r32 * CAND_CAP;
    LAS unsigned* ccnt = (LAS unsigned*)(F.lds + DS_STATE) + 192 + r32;
    const bf16_t* Kb = KIDX + (rowb + r32) * IDXD + hi * 8;
    bf16x8 kn[4];
    if (kstart <= qb) {
#pragma unroll
        for (int s = 0; s < 4; ++s) kn[s] = *(const bf16x8*)(Kb + (size_t)(32 * kstart) * IDXD + s * 16);
    }
    for (int kt = kstart; kt <= qb; kt += kstep) {
        bf16x8 kf[4];
#pragma unroll
        for (int s = 0; s < 4; ++s) kf[s] = kn[s];
        if (kt + kstep <= qb) {
#pragma unroll
            for (int s = 0; s < 4; ++s) kn[s] = *(const bf16x8*)(Kb + (size_t)(32 * (kt + kstep)) * IDXD + s * 16);
        }
        f32x16 sc;
#pragma unroll
        for (int i = 0; i < 16; ++i) sc[i] = 0.f;
#pragma unroll
        for (int h = 0; h < 4; ++h) {
            f32x16 d;
#pragma unroll
            for (int i = 0; i < 16; ++i) d[i] = 0.f;
#pragma unroll
            for (int s = 0; s < 4; ++s) d = __builtin_amdgcn_mfma_f32_32x32x16_bf16(kf[s], Q.qf[h][s], d, 0, 0, 0);
#pragma unroll
            for (int i = 0; i < 16; ++i) { const int db = (int)__float_as_uint(d[i]); sc[i] = __builtin_fmaf(__uint_as_float((unsigned)(db > 0 ? db : 0)), Q.w[h], sc[i]);
                asm("" : "+v"(sc[i])); }
        }
        constexpr bool diag = DIAG;
        int hi_ = lane >> 5, r32_ = lane & 31; asm volatile("" : "+v"(hi_), "+v"(r32_));
        if (MODE == 6) {
            const float thr = __uint_as_float((pre & 0x80000000u) ? (pre ^ 0x80000000u) : ~pre);
            const unsigned idxl = (unsigned)(32 * kt + 4 * hi_);
            unsigned slot[16];
#pragma unroll
            for (int i = 0; i < 16; ++i) { const bool valid = !diag || (crow(i, hi_) <= r32_); slot[i] = 0u;
                if (valid && sc[i] > thr) slot[i] = __hip_atomic_fetch_add(ccnt, 1u, __ATOMIC_RELAXED, __HIP_MEMORY_SCOPE_WORKGROUP); }
#pragma unroll
            for (int i = 0; i < 16; ++i) { const bool valid = !diag || (crow(i, hi_) <= r32_);
                if (valid && sc[i] > thr) { const unsigned s_ = slot[i] < (unsigned)CAND_CAP ? slot[i] : (unsigned)(CAND_CAP - 1);
                    ckey[s_] = __float_as_uint(sc[i]); cidx[s_] = (unsigned short)(idxl + (unsigned)((i & 3) + 8 * (i >> 2))); } }
            bool anyeq = false;
#pragma unroll
            for (int i = 0; i < 16; ++i) { const bool valid = !diag || (crow(i, hi_) <= r32_); anyeq = anyeq || (valid && sc[i] == thr); }
            if (__any(anyeq)) {
#pragma unroll
                for (int i = 0; i < 16; ++i) { const bool valid = !diag || (crow(i, hi_) <= r32_);
                    if (valid && sc[i] == thr) { const unsigned idx = idxl + (unsigned)((i & 3) + 8 * (i >> 2));
                        __hip_atomic_fetch_add(ccnt + 32, 1u, __ATOMIC_RELAXED, __HIP_MEMORY_SCOPE_WORKGROUP);
                        __hip_atomic_fetch_or(bmap + (idx >> 5), 1u << (idx & 31u), __ATOMIC_RELAXED, __HIP_MEMORY_SCOPE_WORKGROUP); } }
            }
            continue;
        }
#pragma unroll
        for (int g = 0; g < 4; ++g) {
            unsigned ord = 0u;
#pragma unroll
            for (int q = 0; q < 4; ++q) {
                const int i = 4 * g + q; const int kr = crow(i, hi);
                const bool valid = !diag || (kr <= r32);
                const unsigned idx = (unsigned)(32 * kt + kr);
                const unsigned key = f2key(sc[i]);
                if (MODE == 0) { if (valid) { const unsigned bin = key >> 21; __hip_atomic_fetch_add(hist + (bin >> 1), 1u << ((bin & 1u) * 16u), __ATOMIC_RELAXED, __HIP_MEMORY_SCOPE_WORKGROUP); } }
                else if (MODE == 1) { if (valid && (key >> 21) == pre) { const unsigned bin = (key >> 10) & 2047u; __hip_atomic_fetch_add(hist + (bin >> 1), 1u << ((bin & 1u) * 16u), __ATOMIC_RELAXED, __HIP_MEMORY_SCOPE_WORKGROUP); } }
                else if (MODE == 2) { if (valid && (key >> 10) == pre) { const unsigned bin = key & 1023u; __hip_atomic_fetch_add(hist + (bin >> 1), 1u << ((bin & 1u) * 16u), __ATOMIC_RELAXED, __HIP_MEMORY_SCOPE_WORKGROUP); } }
                else if (MODE == 3) { if (valid && need && key == pre) { const unsigned bin = idx >> 2; __hip_atomic_fetch_add(hist + (bin >> 1), 1u << ((bin & 1u) * 16u), __ATOMIC_RELAXED, __HIP_MEMORY_SCOPE_WORKGROUP); } }
                else if (MODE == 4) {
                    const bool tie = valid && (key == pre);
                    const unsigned grp = idx >> 2;
                    const bool take = valid && ((key > pre) || (tie && (grp < tieB || (grp == tieB && ord < tieR))));
                    if (tie) ++ord;
                    if (take) __hip_atomic_fetch_or(bmap + (idx >> 5), 1u << (idx & 31u), __ATOMIC_RELAXED, __HIP_MEMORY_SCOPE_WORKGROUP);
                }
                else if (MODE == 5) { if (valid) { const unsigned bin = bin11(key); __hip_atomic_fetch_add(hist + (bin >> 1), 1u << ((bin & 1u) * 16u), __ATOMIC_RELAXED, __HIP_MEMORY_SCOPE_WORKGROUP); } }
                else { }
            }
        }
    }
}

template <int MODE>
DI void dsa_pass(Ctx& F, const DsaQ& Q, const bf16_t* KIDX, size_t rowb, int qb, unsigned pre, unsigned tieB, unsigned tieR, unsigned need) {
    const int kstart = (MODE == 5) ? SAMPLE_STRIDE * F.wave : F.wave, kstep = (MODE == 5) ? 8 * SAMPLE_STRIDE : 8;
    dsa_pass_impl<MODE, false>(F, Q, KIDX, rowb, qb - 1, kstart, kstep, pre, tieB, tieR, need);
    if (qb >= kstart && ((qb - kstart) % kstep) == 0) dsa_pass_impl<MODE, true>(F, Q, KIDX, rowb, qb, qb, kstep, pre, tieB, tieR, need);
}

template <int MODE>
DI void dsa_scan(Ctx& F) {
    LAS unsigned* hist = (LAS unsigned*)(F.lds + DS_HIST);
    LAS unsigned* st = (LAS unsigned*)(F.lds + DS_STATE);
    LAS unsigned* csum = (LAS unsigned*)(F.lds + DS_CSUM);
    const int q = F.tid & 31, j = F.tid >> 5;
    LAS unsigned* hw = hist + q * 1025 + 64 * j;
    __syncthreads();
    unsigned s = 0u;
#pragma unroll 8
    for (int w = 0; w < 64; ++w) { const unsigned v = hw[w]; s += (v & 0xffffu) + (v >> 16); }
    csum[q * 16 + j] = s;
    __syncthreads();
    const unsigned rank = st[32 + q];
    const bool active = (MODE != 3) || (st[128 + q] != 0u);
    unsigned before = 0u;
    { const u32x4 c0 = *(const LAS u32x4*)(csum + q * 16), c1 = *(const LAS u32x4*)(csum + q * 16 + 4), c2 = *(const LAS u32x4*)(csum + q * 16 + 8), c3 = *(const LAS u32x4*)(csum + q * 16 + 12);
      const unsigned cs[16] = {c0.x, c0.y, c0.z, c0.w, c1.x, c1.y, c1.z, c1.w, c2.x, c2.y, c2.z, c2.w, c3.x, c3.y, c3.z, c3.w};
#pragma unroll
      for (int k = 0; k < 16; ++k) before += ((MODE != 3) ? (k > j) : (k < j)) ? cs[k] : 0u; }
    if (active && before < rank && rank <= before + s) {
        unsigned c = before, bin = 0u, cb = 0u, m = 0u; bool found = false;
        if (MODE != 3) {
#pragma unroll 1
            for (int w0 = 60; w0 >= 0 && !found; w0 -= 4) {
                const unsigned vv[4] = {hw[w0 + 3], hw[w0 + 2], hw[w0 + 1], hw[w0]};
#pragma unroll
                for (int e = 0; e < 4; ++e) if (!found) { const int w = w0 + 3 - e; const unsigned v = vv[e]; const unsigned h1 = v >> 16, h0 = v & 0xffffu;
                    if (c + h1 >= rank) { bin = 128u * j + 2u * w + 1u; cb = c; m = h1; found = true; }
                    else { c += h1; if (c + h0 >= rank) { bin = 128u * j + 2u * w; cb = c; m = h0; found = true; } else c += h0; } } }
        } else {
#pragma unroll 1
            for (int w = 0; w < 64 && !found; ++w) { const unsigned v = hw[w]; const unsigned h1 = v >> 16, h0 = v & 0xffffu;
                if (c + h0 >= rank) { bin = 128u * j + 2u * w; cb = c; m = h0; found = true; }
                else { c += h0; if (c + h1 >= rank) { bin = 128u * j + 2u * w + 1u; cb = c; m = h1; found = true; } else c += h1; } }
        }
        const unsigned r = rank - cb;
        if (MODE == 5) { st[q] = bin11_lokey(bin); }
        else if (MODE == 0) { st[q] = bin; st[32 + q] = r; }
        else if (MODE == 1) { st[q] = (st[q] << 11) | bin; st[32 + q] = r; }
        else if (MODE == 2) { st[q] = (st[q] << 10) | bin; st[32 + q] = r; const unsigned nd = (r < m) ? 1u : 0u; st[128 + q] = nd; st[64 + q] = 0x7fffffffu; st[96 + q] = 0u; if (nd) st[160] = 1u; }
        else { st[64 + q] = bin; st[96 + q] = r; }
    }
    __syncthreads();
#pragma unroll 8
    for (int w = 0; w < 64; ++w) hw[w] = 0u;
    if (j == 15) hw[64] = 0u;
    __syncthreads();
}

template <int DUMMY>
DI void dsa_attend(Ctx& F, const bf16_t* P, const bf16_t* CKV, bf16_t* OLAT, size_t rowb, int t, int qi) {
    int lane_ = F.lane; asm volatile("" : "+v"(lane_));
    const int lane = lane_, hd = lane & 15, g = lane >> 4;
    LAS unsigned char* stg = F.lds + DS_STAGE + F.wave * STG_WAVE;
    const LAS unsigned short* sel = (const LAS unsigned short*)(F.lds + DS_SEL) + qi * 256;
    const LAS float* lut = (const LAS float*)(F.lds + DS_LUT);
    int cnt = (int)((const LAS unsigned*)(F.lds + DS_SELCNT))[qi]; cnt = cnt > 256 ? 256 : cnt;
    bf16x8 ql[4];
    { const bf16_t* qp = P + (rowb + t) * NCOL + PC_QLAT + (hd & 7) * 128 + 8 * g;
#pragma unroll
      for (int ks = 0; ks < 4; ++ks) { ql[ks] = *(const bf16x8*)(qp + 32 * ks); if (hd >= 8) ql[ks] = (bf16x8){0, 0, 0, 0, 0, 0, 0, 0}; } }
    f32x4 O[8];
#pragma unroll
    for (int c = 0; c < 8; ++c) O[c] = (f32x4){0.f, 0.f, 0.f, 0.f};
    float m_run = -1e30f, l_run = 0.f;
    const char* cbase = (const char*)(CKV + rowb * KVR);
    const unsigned lo16 = (unsigned)hd * 16u;
    const LAS unsigned short* selp = sel + 4 * g;
    unsigned ka[8], kb[8]; u32x4 gva[8], gvb[8];
#define ATT_KEYS(K, C0) do { _Pragma("unroll") for (int a = 0; a < 2; ++a) { const u32x2 w_ = *(const LAS u32x2*)(selp + (C0) + 16 * a); K[4 * a] = w_.x & 0xffffu; K[4 * a + 1] = w_.x >> 16; K[4 * a + 2] = w_.y & 0xffffu; K[4 * a + 3] = w_.y >> 16; } } while (0)
#define ATT_LOAD(GV, K) do { _Pragma("unroll") for (int j = 0; j < 8; ++j) GV[j] = *(const u32x4*)(cbase + ((DUMMY == 2 ? 0u : K[j]) * 256u + lo16)); } while (0)
#define ATT_CHUNK(GV, K, KN, GVN, C0) do { \
        LDS_WAIT(); \
        _Pragma("unroll") for (int j = 0; j < 8; ++j) *(LAS u32x4*)(stg + (16 * (j >> 2) + 4 * g + (j & 3)) * STG_ROW + lo16) = GV[j]; \
        unsigned kc[8]; _Pragma("unroll") for (int j = 0; j < 8; ++j) kc[j] = K[j]; \
        if ((C0) + 64 < cnt) { ATT_KEYS(KN, (C0) + 64); ATT_LOAD(GVN, KN); } \
        f32x4 S[2]; \
        _Pragma("unroll") for (int a = 0; a < 2; ++a) { S[a] = (f32x4){0.f, 0.f, 0.f, 0.f}; \
            _Pragma("unroll") for (int ks = 0; ks < 4; ++ks) { const bf16x8 cf = *(const LAS bf16x8*)(stg + (16 * a + hd) * STG_ROW + (32 * ks + 8 * g) * 2); \
                S[a] = __builtin_amdgcn_mfma_f32_16x16x32_bf16(cf, ql[ks], S[a], 0, 0, 0); } } \
        float mx = -1e30f; \
        _Pragma("unroll") for (int a = 0; a < 2; ++a) _Pragma("unroll") for (int i = 0; i < 4; ++i) { const int slot = (C0) + 16 * a + 4 * g + i; \
                int dd = t - (int)kc[4 * a + i]; dd = dd < 0 ? 0 : (dd > 128 ? 128 : dd); \
                float v = S[a][i] + lut[dd * 8 + (hd & 7)]; v = (slot < cnt) ? v : -1e30f; S[a][i] = v; mx = fmaxf(mx, v); } \
        if (__any(mx > m_run + 8.0f)) {     \
            mx = fmaxf(mx, __shfl_xor(mx, 16)); mx = fmaxf(mx, __shfl_xor(mx, 32)); \
            const float m_new = fmaxf(m_run, mx); const float alpha = fast_exp2((m_run - m_new) * LOG2E); \
            l_run *= alpha; m_run = m_new; \
            float al[4]; _Pragma("unroll") for (int i = 0; i < 4; ++i) al[i] = __shfl(alpha, 4 * g + i); \
            _Pragma("unroll") for (int c = 0; c < 8; ++c) _Pragma("unroll") for (int i = 0; i < 4; ++i) O[c][i] *= al[i]; \
        } \
        float ps = 0.f; \
        _Pragma("unroll") for (int a = 0; a < 2; ++a) _Pragma("unroll") for (int i = 0; i < 4; ++i) { const float p = fast_exp2((S[a][i] - m_run) * LOG2E); S[a][i] = p; ps += p; } \
        l_run += ps; \
        u32x4 pw; pw.x = cvt_pk_bf16(S[0][0], S[0][1]); pw.y = cvt_pk_bf16(S[0][2], S[0][3]); pw.z = cvt_pk_bf16(S[1][0], S[1][1]); pw.w = cvt_pk_bf16(S[1][2], S[1][3]); \
        const lds_cptr tb = (lds_cptr)stg + (4 * g + (hd >> 2)) * STG_ROW + 8 * (hd & 3); \
        _Pragma("unroll") for (int c = 0; c < 8; ++c) { \
            const s16x4 lo = vtr(tb + 32 * c), hv = vtr(tb + 16 * STG_ROW + 32 * c); \
            const bf16x8 cf = (bf16x8){lo[0], lo[1], lo[2], lo[3], hv[0], hv[1], hv[2], hv[3]}; \
            O[c] = __builtin_amdgcn_mfma_f32_16x16x32_bf16(__builtin_bit_cast(bf16x8, pw), cf, O[c], 0, 0, 0); } \
    } while (0)
    ATT_KEYS(ka, 0); ATT_LOAD(gva, ka);
    if (32 < cnt) { ATT_KEYS(kb, 32); ATT_LOAD(gvb, kb); }
    for (int c0 = 0; c0 < cnt; c0 += 64) {
        ATT_CHUNK(gva, ka, ka, gva, c0);
        if (c0 + 32 < cnt) ATT_CHUNK(gvb, kb, kb, gvb, c0 + 32);
    }
#undef ATT_KEYS
#undef ATT_LOAD
#undef ATT_CHUNK
    l_run += __shfl_xor(l_run, 16); l_run += __shfl_xor(l_run, 32);
    const float inv = 1.0f / l_run;
    float iv[4];
#pragma unroll
    for (int i = 0; i < 4; ++i) iv[i] = __shfl(inv, 4 * g + i);
    if (DUMMY) {
#pragma unroll
        for (int c = 0; c < 8; ++c) asm volatile("" :: "v"(O[c][0] * iv[0]), "v"(O[c][1] * iv[1]), "v"(O[c][2] * iv[2]), "v"(O[c][3] * iv[3]));
    } else if (g < 2) {
        unsigned char* op = (unsigned char*)OLAT + (rowb + t) * 1024 + hd;
#pragma unroll
        for (int c = 0; c < 8; ++c) { const unsigned pk = pack_fp8x4(O[c][0] * iv[0] * OLAT_SCALE, O[c][1] * iv[1] * OLAT_SCALE, O[c][2] * iv[2] * OLAT_SCALE, O[c][3] * iv[3] * OLAT_SCALE);
#pragma unroll
            for (int i = 0; i < 4; ++i) op[(4 * g + i) * 128 + 16 * c] = (unsigned char)((pk >> (8 * i)) & 0xffu); }
    }
}

constexpr int ST8_ROW = 144;
constexpr float QL8_SCALE = 16.0f, P8_SCALE = 32.0f;
static_assert(QL8_SCALE == QLAT8_SCALE, "q_lat fp8 scale: in-projection epilogue and sparse attention agree");
DI long mk64(unsigned lo, unsigned hi) { return (long)(((unsigned long long)hi << 32) | (unsigned long long)lo); }
DI void dsa_attend8(Ctx& F, const bf16_t* P, const unsigned char* CKV8, bf16_t* OLAT, size_t rowb, int t, int qi) {
    int lane_ = F.lane; asm volatile("" : "+v"(lane_));
    const int lane = lane_, hd = lane & 15, g = lane >> 4;
    LAS unsigned char* stg = F.lds + DS_STAGE + F.wave * STG_WAVE;
    const LAS unsigned short* sel = (const LAS unsigned short*)(F.lds + DS_SEL) + qi * 256;
    const LAS float* lut = (const LAS float*)(F.lds + DS_LUT);
    int cnt = (int)((const LAS unsigned*)(F.lds + DS_SELCNT))[qi]; cnt = cnt > 256 ? 256 : cnt;
    long qf8[4];
    { const bf16_t* qp = P + (rowb + t) * NCOL + PC_QLAT + (hd & 7) * 128 + 8 * g;
#pragma unroll
      for (int ks = 0; ks < 4; ++ks) { const u32x4 w = *(const u32x4*)(qp + 32 * ks);
          const unsigned lo = pack_fp8x4(bf_lo(w.x) * QL8_SCALE, bf_hi(w.x) * QL8_SCALE, bf_lo(w.y) * QL8_SCALE, bf_hi(w.y) * QL8_SCALE), hi = pack_fp8x4(bf_lo(w.z) * QL8_SCALE, bf_hi(w.z) * QL8_SCALE, bf_lo(w.w) * QL8_SCALE, bf_hi(w.w) * QL8_SCALE);
          qf8[ks] = (hd < 8) ? mk64(lo, hi) : 0L; } }
    f32x4 O[8];
#pragma unroll
    for (int c = 0; c < 8; ++c) O[c] = (f32x4){0.f, 0.f, 0.f, 0.f};
    float m_run = -1e30f, l_run = 0.f;
    const unsigned char* cbase = CKV8 + rowb * KVR;
    const int grow = lane >> 3; const unsigned gl16 = (unsigned)(lane & 7) * 16u;
    const LAS unsigned short* selp = sel + 4 * g;
    unsigned ka[4], kb[4]; u32x4 gva[4], gvb[4];
#define A8_KEYS(K, C0) do { _Pragma("unroll") for (int i = 0; i < 4; ++i) K[i] = (unsigned)sel[(C0) + 8 * i + grow]; } while (0)
#define A8_LOAD(GV, K) do { _Pragma("unroll") for (int i = 0; i < 4; ++i) GV[i] = *(const u32x4*)(cbase + (K[i] * 128u + gl16)); } while (0)
#define A8_CHUNK(GV, K, C0) do { \
        LDS_WAIT(); \
        _Pragma("unroll") for (int i = 0; i < 4; ++i) { const int s_ = 8 * i + grow; *(LAS u32x4*)(stg + (8 * ((s_ >> 2) & 3) + 4 * (s_ >> 4) + (s_ & 3)) * ST8_ROW + gl16) = GV[i]; } \
        unsigned kc[8]; \
        _Pragma("unroll") for (int a = 0; a < 2; ++a) { const u32x2 w_ = *(const LAS u32x2*)(selp + (C0) + 16 * a); kc[4 * a] = w_.x & 0xffffu; kc[4 * a + 1] = w_.x >> 16; kc[4 * a + 2] = w_.y & 0xffffu; kc[4 * a + 3] = w_.y >> 16; } \
        if ((C0) + 64 < cnt) { A8_KEYS(K, (C0) + 64); A8_LOAD(GV, K); } \
        f32x4 S[2]; \
        _Pragma("unroll") for (int a = 0; a < 2; ++a) { S[a] = (f32x4){0.f, 0.f, 0.f, 0.f}; \
            _Pragma("unroll") for (int ks = 0; ks < 4; ++ks) { const u32x2 af = *(const LAS u32x2*)(stg + (8 * (hd >> 2) + 4 * a + (hd & 3)) * ST8_ROW + 32 * ks + 8 * g); \
                S[a] = __builtin_amdgcn_mfma_f32_16x16x32_fp8_fp8(mk64(af.x, af.y), qf8[ks], S[a], 0, 0, 0); } } \
        float mx = -1e30f; \
        _Pragma("unroll") for (int a = 0; a < 2; ++a) _Pragma("unroll") for (int i = 0; i < 4; ++i) { const int slot = (C0) + 16 * a + 4 * g + i; \
                int dd = t - (int)kc[4 * a + i]; dd = dd < 0 ? 0 : (dd > 128 ? 128 : dd); \
                float v = S[a][i] * (1.0f / QL8_SCALE) + lut[dd * 8 + (hd & 7)]; v = (slot < cnt) ? v : -1e30f; S[a][i] = v; mx = fmaxf(mx, v); } \
        if (__any(mx > m_run + 2.0f)) {     \
            mx = fmaxf(mx, __shfl_xor(mx, 16)); mx = fmaxf(mx, __shfl_xor(mx, 32)); \
            const float m_new = fmaxf(m_run, mx); const float alpha = fast_exp2((m_run - m_new) * LOG2E); \
            l_run *= alpha; m_run = m_new; \
            float al[4]; _Pragma("unroll") for (int i = 0; i < 4; ++i) al[i] = __shfl(alpha, 4 * g + i); \
            _Pragma("unroll") for (int c = 0; c < 8; ++c) _Pragma("unroll") for (int i = 0; i < 4; ++i) O[c][i] *= al[i]; \
        } \
        float ps = 0.f; \
        _Pragma("unroll") for (int a = 0; a < 2; ++a) _Pragma("unroll") for (int i = 0; i < 4; ++i) { const float p = fast_exp2((S[a][i] - m_run) * LOG2E); S[a][i] = p * P8_SCALE; ps += p; } \
        l_run += ps; \
        const long pw = mk64(pack_fp8x4(S[0][0], S[0][1], S[0][2], S[0][3]), pack_fp8x4(S[1][0], S[1][1], S[1][2], S[1][3])); \
        const LAS unsigned char* tb = stg + (8 * g + (hd >> 1)) * ST8_ROW + 8 * (hd & 1); \
        _Pragma("unroll") for (int c = 0; c < 8; ++c) { \
            const v2i_t cf = __builtin_amdgcn_ds_read_tr8_b64_v2i32((LAS v2i_t*)(tb + 16 * c)); \
            O[c] = __builtin_amdgcn_mfma_f32_16x16x32_fp8_fp8(pw, mk64((unsigned)cf.x, (unsigned)cf.y), O[c], 0, 0, 0); } \
    } while (0)
    A8_KEYS(ka, 0); A8_LOAD(gva, ka);
    if (32 < cnt) { A8_KEYS(kb, 32); A8_LOAD(gvb, kb); }
    for (int c0 = 0; c0 < cnt; c0 += 64) {
        A8_CHUNK(gva, ka, c0);
        if (c0 + 32 < cnt) A8_CHUNK(gvb, kb, c0 + 32);
    }
#undef A8_KEYS
#undef A8_LOAD
#undef A8_CHUNK
    l_run += __shfl_xor(l_run, 16); l_run += __shfl_xor(l_run, 32);
    const float inv = (OLAT_SCALE / P8_SCALE) / l_run;
    float iv[4];
#pragma unroll
    for (int i = 0; i < 4; ++i) iv[i] = __shfl(inv, 4 * g + i);
    if (g < 2) {
        unsigned char* op = (unsigned char*)OLAT + (rowb + t) * 1024 + hd;
#pragma unroll
        for (int c = 0; c < 8; ++c) { const unsigned pk = pack_fp8x4(O[c][0] * iv[0], O[c][1] * iv[1], O[c][2] * iv[2], O[c][3] * iv[3]);
#pragma unroll
            for (int i = 0; i < 4; ++i) op[(4 * g + i) * 128 + 16 * c] = (unsigned char)((pk >> (8 * i)) & 0xffu); }
    }
}

constexpr int ST8_Q = 32 * ST8_ROW, ST8_WAVE = 2 * ST8_Q;
static_assert(8 * ST8_WAVE <= DS_BMAP, "fp8 stage overlay");
template <int NZ>
DI void dsa_attend8z(Ctx& F, const bf16_t* P, const unsigned char* CKV8, bf16_t* OLAT, size_t rowb, int tq0, int qi0) {
    int lane_ = F.lane; asm volatile("" : "+v"(lane_));
    const int lane = lane_, hd = lane & 15, g = lane >> 4;
    LAS unsigned char* stg0 = F.lds + DS_STAGE + F.wave * ST8_WAVE;
    const LAS unsigned short* sel0 = (const LAS unsigned short*)(F.lds + DS_SEL) + qi0 * 256;
    const LAS float* lut = (const LAS float*)(F.lds + DS_LUT);
    const float farb = lut[128 * 8 + (hd & 7)];
    int cnt[NZ]; int cmax = 0;
#pragma unroll
    for (int z = 0; z < NZ; ++z) { int c_ = (int)((const LAS unsigned*)(F.lds + DS_SELCNT))[qi0 + z]; c_ = c_ > 256 ? 256 : c_; cnt[z] = c_; cmax = c_ > cmax ? c_ : cmax; }
    i32x8 qf8[NZ];
#pragma unroll
    for (int z = 0; z < NZ; ++z) { const unsigned char* qp = (const unsigned char*)(P + (rowb + tq0 + z) * NCOL) + PC_QLAT + (hd & 7) * 128 + 32 * g;
        const u32x4 w0 = *(const u32x4*)qp, w1 = *(const u32x4*)(qp + 16);
        qf8[z][0] = (hd < 8) ? (int)w0.x : 0; qf8[z][1] = (hd < 8) ? (int)w0.y : 0; qf8[z][2] = (hd < 8) ? (int)w0.z : 0; qf8[z][3] = (hd < 8) ? (int)w0.w : 0;
        qf8[z][4] = (hd < 8) ? (int)w1.x : 0; qf8[z][5] = (hd < 8) ? (int)w1.y : 0; qf8[z][6] = (hd < 8) ? (int)w1.z : 0; qf8[z][7] = (hd < 8) ? (int)w1.w : 0; }
    f32x4 O[NZ][8];
    float m_run[NZ], l_run[NZ];
#pragma unroll
    for (int z = 0; z < NZ; ++z) { m_run[z] = -1e30f; l_run[z] = 0.f;
#pragma unroll
        for (int c = 0; c < 8; ++c) O[z][c] = (f32x4){0.f, 0.f, 0.f, 0.f}; }
    const unsigned char* cbase = CKV8 + rowb * KVR;
    const int grow = lane >> 3; const unsigned gl16 = (unsigned)(lane & 7) * 16u;
    const int wrow = (8 * (grow & 3) + 4 * (grow >> 2)) * ST8_ROW + (int)gl16;
    u32x4 gv[NZ][4];
#define A8Z_LOAD(C0) do { _Pragma("unroll") for (int z = 0; z < NZ; ++z) { const u32x2 kw_ = *(const LAS u32x2*)(sel0 + z * 256 + (C0) + 4 * grow); \
        gv[z][0] = *(const u32x4*)(cbase + ((kw_.x & 0xffffu) * 128u + gl16)); gv[z][1] = *(const u32x4*)(cbase + ((kw_.x >> 16) * 128u + gl16)); \
        gv[z][2] = *(const u32x4*)(cbase + ((kw_.y & 0xffffu) * 128u + gl16)); gv[z][3] = *(const u32x4*)(cbase + ((kw_.y >> 16) * 128u + gl16)); } } while (0)
    A8Z_LOAD(0);
#pragma unroll 1
    for (int c0 = 0; c0 < cmax; c0 += 32) {
        LDS_WAIT();
#pragma unroll
        for (int z = 0; z < NZ; ++z)
#pragma unroll
            for (int i = 0; i < 4; ++i) *(LAS u32x4*)(stg0 + z * ST8_Q + wrow + i * ST8_ROW) = gv[z][i];
        if (c0 + 32 < cmax) A8Z_LOAD(c0 + 32);
        f32x4 S[NZ][2];
#pragma unroll
        for (int z = 0; z < NZ; ++z) {
            const LAS unsigned char* ar = stg0 + z * ST8_Q + (8 * (hd >> 2) + (hd & 3)) * ST8_ROW + 32 * g;
            const i32x8 a0 = __builtin_shufflevector(*(const LAS i32x4*)ar, *(const LAS i32x4*)(ar + 16), 0, 1, 2, 3, 4, 5, 6, 7);
            const i32x8 a1 = __builtin_shufflevector(*(const LAS i32x4*)(ar + 4 * ST8_ROW), *(const LAS i32x4*)(ar + 4 * ST8_ROW + 16), 0, 1, 2, 3, 4, 5, 6, 7);
            asm volatile("v_mfma_f32_16x16x128_f8f6f4 %0, %2, %4, 0\n\tv_mfma_f32_16x16x128_f8f6f4 %1, %3, %4, 0\n\ts_nop 15\n\ts_nop 7"
                         : "=&v"(S[z][0]), "=&v"(S[z][1]) : "v"(a0), "v"(a1), "v"(qf8[z]));
        }
        float mx[NZ];
#pragma unroll
        for (int z = 0; z < NZ; ++z) { mx[z] = -1e30f;
            unsigned kc[8];
#pragma unroll
            for (int a = 0; a < 2; ++a) { const u32x2 w_ = *(const LAS u32x2*)(sel0 + z * 256 + 4 * g + c0 + 16 * a); kc[4 * a] = w_.x & 0xffffu; kc[4 * a + 1] = w_.x >> 16; kc[4 * a + 2] = w_.y & 0xffffu; kc[4 * a + 3] = w_.y >> 16; }
            bool nearb = false;
#pragma unroll
            for (int j = 0; j < 8; ++j) nearb = nearb || ((tq0 + z) - (int)kc[j] < 128);
            float bias[8];
            if (__any(nearb)) {
#pragma unroll
                for (int j = 0; j < 8; ++j) { int dd = (tq0 + z) - (int)kc[j]; dd = dd < 0 ? 0 : (dd > 128 ? 128 : dd); bias[j] = lut[dd * 8 + (hd & 7)]; }
            } else {
#pragma unroll
                for (int j = 0; j < 8; ++j) bias[j] = farb;
            }
#pragma unroll
            for (int a = 0; a < 2; ++a)
#pragma unroll
                for (int i = 0; i < 4; ++i) { const int slot = c0 + 16 * a + 4 * g + i;
                    float v = S[z][a][i] * (1.0f / QL8_SCALE) + bias[4 * a + i]; v = (slot < cnt[z]) ? v : -1e30f; S[z][a][i] = v; mx[z] = fmaxf(mx[z], v); } }
#pragma unroll
        for (int z = 0; z < NZ; ++z)
            if (__any(mx[z] > m_run[z] + 2.0f)) {
                float mm = fmaxf(mx[z], __shfl_xor(mx[z], 16)); mm = fmaxf(mm, __shfl_xor(mm, 32));
                const float m_new = fmaxf(m_run[z], mm); const float alpha = fast_exp2((m_run[z] - m_new) * LOG2E);
                l_run[z] *= alpha; m_run[z] = m_new;
                float al[4];
#pragma unroll
                for (int i = 0; i < 4; ++i) al[i] = __shfl(alpha, 4 * g + i);
#pragma unroll
                for (int c = 0; c < 8; ++c)
#pragma unroll
                    for (int i = 0; i < 4; ++i) O[z][c][i] *= al[i];
            }
        long pw[NZ];
#pragma unroll
        for (int z = 0; z < NZ; ++z) { float ps = 0.f;
#pragma unroll
            for (int a = 0; a < 2; ++a)
#pragma unroll
                for (int i = 0; i < 4; ++i) { const float p = fast_exp2((S[z][a][i] - m_run[z]) * LOG2E); S[z][a][i] = p * P8_SCALE; ps += p; }
            l_run[z] += ps;
            pw[z] = mk64(pack_fp8x4(S[z][0][0], S[z][0][1], S[z][0][2], S[z][0][3]), pack_fp8x4(S[z][1][0], S[z][1][1], S[z][1][2], S[z][1][3])); }
#pragma unroll
        for (int c = 0; c < 8; ++c)
#pragma unroll
            for (int z = 0; z < NZ; ++z) {
                const v2i_t cf = __builtin_amdgcn_ds_read_tr8_b64_v2i32((LAS v2i_t*)(stg0 + z * ST8_Q + (8 * g + (hd >> 1)) * ST8_ROW + 8 * (hd & 1) + 16 * c));
                O[z][c] = __builtin_amdgcn_mfma_f32_16x16x32_fp8_fp8(pw[z], mk64((unsigned)cf.x, (unsigned)cf.y), O[z][c], 0, 0, 0); }
    }
#undef A8Z_LOAD
#pragma unroll
    for (int z = 0; z < NZ; ++z) {
        float lr = l_run[z]; lr += __shfl_xor(lr, 16); lr += __shfl_xor(lr, 32);
        const float inv = (OLAT_SCALE / P8_SCALE) / lr;
        float iv[4];
#pragma unroll
        for (int i = 0; i < 4; ++i) iv[i] = __shfl(inv, 4 * g + i);
        if (g < 2) {
            unsigned char* op = (unsigned char*)OLAT + (rowb + tq0 + z) * 1024 + hd;
#pragma unroll
            for (int c = 0; c < 8; ++c) { const unsigned pk = pack_fp8x4(O[z][c][0] * iv[0], O[z][c][1] * iv[1], O[z][c][2] * iv[2], O[z][c][3] * iv[3]);
#pragma unroll
                for (int i = 0; i < 4; ++i) op[(4 * g + i) * 128 + 16 * c] = (unsigned char)((pk >> (8 * i)) & 0xffu); }
        }
    }
}

template <bool DESC, int NQ>
DI void radix_step4(LAS unsigned* wh, int lane, const unsigned (&v)[NQ][8], const unsigned (&act)[NQ], int shift, unsigned (&rank)[NQ], unsigned (&m)[NQ], unsigned (&bin)[NQ]) {
#pragma unroll
    for (int q = 0; q < NQ; ++q) { wh[q * 128 + 2 * lane] = 0u; wh[q * 128 + 2 * lane + 1] = 0u; }
#pragma unroll
    for (int q = 0; q < NQ; ++q)
#pragma unroll
        for (int j = 0; j < 8; ++j) if ((act[q] >> j) & 1u) { const unsigned b = (v[q][j] >> shift) & 255u; __hip_atomic_fetch_add(wh + q * 128 + (b >> 1), 1u << ((b & 1u) * 16u), __ATOMIC_RELAXED, __HIP_MEMORY_SCOPE_WORKGROUP); }
    unsigned c0[NQ], c1[NQ], c2[NQ], c3[NQ], S[NQ], incl[NQ];
#pragma unroll
    for (int q = 0; q < NQ; ++q) { const unsigned v0 = wh[q * 128 + 2 * lane], v1 = wh[q * 128 + 2 * lane + 1]; c0[q] = v0 & 0xffffu; c1[q] = v0 >> 16; c2[q] = v1 & 0xffffu; c3[q] = v1 >> 16; S[q] = c0[q] + c1[q] + c2[q] + c3[q]; incl[q] = S[q]; }
#pragma unroll
    for (int o = 1; o < 64; o <<= 1)
#pragma unroll
        for (int q = 0; q < NQ; ++q) { const unsigned n = DESC ? __shfl_down(incl[q], o) : __shfl_up(incl[q], o); if (DESC ? (lane + o < 64) : (lane >= o)) incl[q] += n; }
#pragma unroll
    for (int q = 0; q < NQ; ++q) {
        const unsigned out = incl[q] - S[q], rk = rank[q];
        const bool hit = (out < rk) && (rk <= incl[q]);
        unsigned b = 0u, cb = out, mm = 0u;
        if (DESC) { if (cb + c3[q] >= rk) { b = 3u; mm = c3[q]; } else { cb += c3[q]; if (cb + c2[q] >= rk) { b = 2u; mm = c2[q]; } else { cb += c2[q]; if (cb + c1[q] >= rk) { b = 1u; mm = c1[q]; } else { cb += c1[q]; b = 0u; mm = c0[q]; } } } }
        else      { if (cb + c0[q] >= rk) { b = 0u; mm = c0[q]; } else { cb += c0[q]; if (cb + c1[q] >= rk) { b = 1u; mm = c1[q]; } else { cb += c1[q]; if (cb + c2[q] >= rk) { b = 2u; mm = c2[q]; } else { cb += c2[q]; b = 3u; mm = c3[q]; } } } }
        b += 4u * (unsigned)lane;
        const unsigned long long bal = __ballot(hit);
        const int src = bal ? __builtin_ctzll(bal) : 0;
        bin[q] = (unsigned)__builtin_amdgcn_readlane((int)b, src); cb = (unsigned)__builtin_amdgcn_readlane((int)cb, src); m[q] = (unsigned)__builtin_amdgcn_readlane((int)mm, src);
        rank[q] = rk - cb;
    }
}
template <int NQ, int DUMMY>
DI void dsa_finish4(Ctx& F, int q0) {
    int lane_ = F.lane; asm volatile("" : "+v"(lane_));
    const int lane = lane_;
    const LAS unsigned* st = (const LAS unsigned*)(F.lds + DS_STATE);
    LAS unsigned* wh = (LAS unsigned*)(F.lds + DS_SEL) + F.wave * 512 + q0 * 128;
    unsigned K[NQ][8], I[NQ][8], valid[NQ]; int c[NQ];
#pragma unroll
    for (int q = 0; q < NQ; ++q) { const int qi = 4 * F.wave + q0 + q; c[q] = (int)st[192 + qi];
        const LAS unsigned* ck = (const LAS unsigned*)(F.lds + DS_CKEY) + qi * CAND_CAP; const LAS unsigned short* ci = (const LAS unsigned short*)(F.lds + DS_CIDX) + qi * CAND_CAP;
        valid[q] = 0u;
#pragma unroll
        for (int j = 0; j < 8; ++j) { const int s = j * 64 + lane; K[q][j] = f2key(__uint_as_float(ck[s])); I[q][j] = (unsigned)ci[s]; valid[q] |= ((s < c[q]) ? 1u : 0u) << j; } }
#pragma unroll 1
    for (int q = 0; q < NQ; ++q) { LAS unsigned* bm = (LAS unsigned*)(F.lds + DS_BMAP) + (4 * F.wave + q0 + q) * 256;
        int cq = c[0];
#pragma unroll
        for (int qq = 1; qq < NQ; ++qq) cq = (q == qq) ? c[qq] : cq;
        if (cq < TOPK) {
            const int r = TOPK - cq;
            u32x4 wv = *(LAS u32x4*)(bm + 4 * lane);
            const int p0 = __builtin_popcount(wv.x), p1 = __builtin_popcount(wv.y), p2 = __builtin_popcount(wv.z), p3 = __builtin_popcount(wv.w);
            const int tot = p0 + p1 + p2 + p3; int inc = tot;
#pragma unroll
            for (int o = 1; o < 64; o <<= 1) { const int n = __shfl_up(inc, o); if (lane >= o) inc += n; }
            int cum = inc - tot;
            unsigned wds[4] = {wv.x, wv.y, wv.z, wv.w};
#pragma unroll
            for (int k = 0; k < 4; ++k) { unsigned w = wds[k]; int pc = __builtin_popcount(w); int keep = r - cum; keep = keep < 0 ? 0 : keep; cum += pc;
                while (pc > keep) { w &= ~(0x80000000u >> __builtin_clz(w)); --pc; }
                wds[k] = w; }
            if (!DUMMY) *(LAS u32x4*)(bm + 4 * lane) = (u32x4){wds[0], wds[1], wds[2], wds[3]}; else asm volatile("" :: "v"(wds[0] ^ wds[1] ^ wds[2] ^ wds[3]));
        } else if (!DUMMY) *(LAS u32x4*)(bm + 4 * lane) = (u32x4){0u, 0u, 0u, 0u};
    }
#pragma unroll
    for (int q = 0; q < NQ; ++q)
#pragma unroll
        for (int j = 0; j < 8; ++j) if (!((valid[q] >> j) & 1u)) { K[q][j] = 0u; I[q][j] = 0xffffu; }
    unsigned prefix[NQ], icut[NQ]; bool tie[NQ]; unsigned rr[NQ];
#pragma unroll
    for (int q = 0; q < NQ; ++q) { prefix[q] = 0u; icut[q] = 0xffffu; tie[q] = false; rr[q] = 0u; }
#define CNT_GE(q, v) ({ int n_ = 0; _Pragma("unroll") for (int j = 0; j < 8; ++j) n_ += __builtin_popcountll(__ballot(K[q][j] >= (v))); n_; })
    unsigned open_ = 0u;
#pragma unroll
    for (int q = 0; q < NQ; ++q) open_ |= ((c[q] >= TOPK) ? 1u : 0u) << q;
#pragma unroll 1
    for (int b = 31; b >= 0 && open_ != 0u; --b) {
#pragma unroll
        for (int q = 0; q < NQ; ++q) if ((open_ >> q) & 1u) { const unsigned cand = prefix[q] | (1u << b); const int n_ = CNT_GE(q, cand); if (n_ >= TOPK) prefix[q] = cand; if (n_ == TOPK) open_ &= ~(1u << q); }
    }
#pragma unroll
    for (int q = 0; q < NQ; ++q) if (c[q] >= TOPK) {
        const int cge = CNT_GE(q, prefix[q]); const int cgt = (prefix[q] == 0xffffffffu) ? 0 : CNT_GE(q, prefix[q] + 1u);
        const int r = TOPK - cgt, m = cge - cgt;
        tie[q] = r < m; rr[q] = (unsigned)r;
    }
    bool anytie = false;
#pragma unroll
    for (int q = 0; q < NQ; ++q) anytie = anytie || tie[q];
    if (anytie) {
#pragma unroll
        for (int q = 0; q < NQ; ++q) if (tie[q]) {
            unsigned pre = 0u;
#pragma unroll 1
            for (int b = 12; b >= 0; --b) { const unsigned cand = pre | (1u << b); int n_ = 0;
#pragma unroll
                for (int j = 0; j < 8; ++j) n_ += __builtin_popcountll(__ballot(K[q][j] == prefix[q] && I[q][j] < cand));
                if (n_ < (int)rr[q]) pre = cand; }
            icut[q] = pre;
        }
    }
#undef CNT_GE
#pragma unroll
    for (int q = 0; q < NQ; ++q) { LAS unsigned* bm = (LAS unsigned*)(F.lds + DS_BMAP) + (4 * F.wave + q0 + q) * 256;
        const bool sub = c[q] < TOPK;
#pragma unroll
        for (int j = 0; j < 8; ++j) if (((valid[q] >> j) & 1u) && (sub || K[q][j] > prefix[q] || (K[q][j] == prefix[q] && I[q][j] <= icut[q]))) {
            if (!DUMMY) __hip_atomic_fetch_or(bm + (I[q][j] >> 5), 1u << (I[q][j] & 31u), __ATOMIC_RELAXED, __HIP_MEMORY_SCOPE_WORKGROUP); else asm volatile("" :: "v"(I[q][j])); } }
}

#ifdef PROBE_PHASE
#define PTICK(k) do { if (blockIdx.x == 77 && F.tid == 0) { const unsigned long long now_ = __builtin_amdgcn_s_memrealtime(); if ((k) > 50) ((unsigned long long*)(F.ws + WS_CTL + 131072))[k] += now_ - tlast_; tlast_ = now_; } } while (0)
#else
#define PTICK(k) do { } while (0)
#endif
DI void phase_dsa(Ctx& F, int layer) {
#ifdef PROBE_PHASE
    unsigned long long tlast_ = 0;
#endif
    const bf16_t* P = (const bf16_t*)(F.ws + WS_P); const bf16_t* KIDX = (const bf16_t*)(F.ws + WS_KIDX); const bf16_t* CKV = (const bf16_t*)(F.ws + WS_CKV);
    const float* WIDX = (const float*)(F.ws + WS_WIDX); bf16_t* OLAT = (bf16_t*)(F.ws + WS_OLAT);
    const int lane = F.lane, r32 = lane & 31, hi = lane >> 5;
    LAS unsigned* st = (LAS unsigned*)(F.lds + DS_STATE);
    LAS unsigned* selcnt = (LAS unsigned*)(F.lds + DS_SELCNT);
    LAS unsigned* hist = (LAS unsigned*)(F.lds + DS_HIST);
    { LAS float* lut = (LAS float*)(F.lds + DS_LUT);
      for (int u = F.tid; u < 129 * 8; u += 512) { const int d = u >> 3, h = u & 7; int bk;
          if (d < 16) bk = d; else { bk = 16 + (d >= 19) + (d >= 21) + (d >= 24) + (d >= 27) + (d >= 31) + (d >= 35) + (d >= 40) + (d >= 46) + (d >= 52) + (d >= 59) + (d >= 67) + (d >= 77) + (d >= 87) + (d >= 99) + (d >= 113); }
          lut[u] = F.rel_bias[bk * 8 + h]; }
      for (int u = F.tid; u < 32 * 1025; u += 512) hist[u] = 0u; }
    __syncthreads();
    {
        const int b = (F.vcu * NB) / F.G; const size_t rowb = (size_t)b * SEQ;
#pragma unroll 1
        for (;;) {
            if (F.tid == 0) st[170] = __hip_atomic_fetch_add((unsigned*)(F.ctl + CW_DSAQ + layer * NB + b), 1u, RLX_AGENT);
            __syncthreads();
            const int uq = (int)st[170];
            __syncthreads();
            if (uq >= SEQ / 32) {
                if (uq >= SEQ / 32 + NHB * (SEQ / 32) / 8) break;
                sb_unit(F, b * (NHB * (SEQ / 32)) + (uq - SEQ / 32) * 8 + F.wave);
                continue;
            }
            const int qb = SEQ / 32 - 1 - uq, t0 = qb * 32;
#define DSA_LOAD_Q(Q) do { const bf16_t* qp = P + (rowb + t0 + r32) * NCOL + PC_QIDX + hi * 8; \
              _Pragma("unroll") for (int h = 0; h < 4; ++h) _Pragma("unroll") for (int s = 0; s < 4; ++s) Q.qf[h][s] = *(const bf16x8*)(qp + h * 64 + s * 16); \
              const f32x4 w4 = *(const f32x4*)(WIDX + (rowb + t0 + r32) * 4); Q.w[0] = w4.x; Q.w[1] = w4.y; Q.w[2] = w4.z; Q.w[3] = w4.w; } while (0)
            const bool fast = (qb >= 16);
            if (F.tid < 32) { const int q = F.tid;
                st[q] = 0u; st[64 + q] = 0x7fffffffu; st[96 + q] = 0u; st[128 + q] = 0u; st[192 + q] = 0u; st[224 + q] = 0u; selcnt[q] = 0u;
                unsigned rk = TOPK;
                if (fast) { const unsigned n = 32u * qb + q + 1u; const unsigned ns = 32u * ((qb + SAMPLE_STRIDE - 1u) / SAMPLE_STRIDE) + (((qb % SAMPLE_STRIDE) == 0) ? (unsigned)(q + 1) : 0u); rk = (384u * ns + n - 1u) / n; rk = rk < 1u ? 1u : (rk > ns ? ns : rk); }
                st[32 + q] = rk; }
            if (F.tid == 0) { st[160] = (unsigned)lane; st[161] = (unsigned)lane; }
            __syncthreads();
#ifdef PROBE_PHASE
            unsigned long long tp0 = __builtin_amdgcn_s_memrealtime();
#endif
            bool robust = (qb >= 8) && !fast;
            if (fast) {
                DsaQ Q; DSA_LOAD_Q(Q); PTICK(50);

                dsa_pass<5>(F, Q, KIDX, rowb, qb, 0u, 0u, 0u, 0u); __syncthreads(); PTICK(51); dsa_scan<5>(F); PTICK(52);
                dsa_pass<6>(F, Q, KIDX, rowb, qb, st[r32], 0u, 0u, 0u);
#ifdef DBL_COLLECT
                for (int rep = 0; rep < DBL_COLLECT; ++rep) dsa_pass<6>(F, Q, KIDX, rowb, qb, 0xffffffffu - (unsigned)(rep & 1), 0u, 0u, 0u);
#endif
                __syncthreads(); PTICK(53);
                if (F.tid < 32) { const unsigned c = st[192 + F.tid], ce = st[224 + F.tid]; if (c + ce < (unsigned)TOPK || c > (unsigned)CAND_CAP) st[161] = 1u; }
                __syncthreads();
                if (st[161] != 0u) {
                    for (int u = F.tid; u < DS_SEL / 4; u += 512) hist[u] = 0u;
                    if (F.tid < 32) { st[F.tid] = 0u; st[32 + F.tid] = TOPK; }
                    __syncthreads();
                    robust = true;
#ifdef COUNT_FB
                    if (F.tid == 0) __hip_atomic_fetch_add((unsigned*)(F.ctl + 12288), 1u, RLX_AGENT);
#endif
#ifdef PROBE_PHASE
                    if (F.tid == 0) { unsigned long long* ts = (unsigned long long*)(F.ws + WS_CTL + 131072); atomicAdd(&ts[42], 100ull); }
#endif
                } else {
#ifdef DBL_FINISH
                    for (int rep = 0; rep < DBL_FINISH; ++rep) { dsa_finish4<2, 1>(F, 0); dsa_finish4<2, 1>(F, 2); }
#endif
                    dsa_finish4<4, 0>(F, 0);
                }
            }
            if (robust || qb < 8) {
              DsaQ Q; DSA_LOAD_Q(Q);
              if (robust) {
                dsa_pass<0>(F, Q, KIDX, rowb, qb, 0u, 0u, 0u, 0u); dsa_scan<0>(F);
                dsa_pass<1>(F, Q, KIDX, rowb, qb, st[r32], 0u, 0u, 0u); dsa_scan<1>(F);
                dsa_pass<2>(F, Q, KIDX, rowb, qb, st[r32], 0u, 0u, 0u); dsa_scan<2>(F);
                if (st[160] != 0u) { dsa_pass<3>(F, Q, KIDX, rowb, qb, st[r32], 0u, 0u, st[128 + r32]); dsa_scan<3>(F); }
              }
              dsa_pass<4>(F, Q, KIDX, rowb, qb, st[r32], st[64 + r32], st[96 + r32], 0u);
            }
            LDS_WAIT();
            __syncthreads(); if (fast) PTICK(54);
#pragma unroll 1
            for (int qq = 0; qq < 4; ++qq) { const int qi = 4 * F.wave + qq;
                LAS unsigned* bm = (LAS unsigned*)(F.lds + DS_BMAP) + qi * 256 + 4 * lane;
                const u32x4 wv = *(LAS u32x4*)bm; *(LAS u32x4*)bm = (u32x4){0u, 0u, 0u, 0u};
                const int c0 = __builtin_popcount(wv.x), c1 = __builtin_popcount(wv.y), c2 = __builtin_popcount(wv.z), c3 = __builtin_popcount(wv.w);
                const int tot = c0 + c1 + c2 + c3; int inc = tot;
#pragma unroll
                for (int o = 1; o < 64; o <<= 1) { const int n = __shfl_up(inc, o); if (lane >= o) inc += n; }
                int pos = inc - tot;
                LAS unsigned short* sl = (LAS unsigned short*)(F.lds + DS_SEL) + qi * 256;
                unsigned wds[4] = {wv.x, wv.y, wv.z, wv.w};
#pragma unroll
                for (int k = 0; k < 4; ++k) { unsigned m = wds[k]; while (m) { const int bit = __builtin_ctz(m); m &= m - 1u; if (pos < 256) sl[pos] = (unsigned short)(128 * lane + 32 * k + bit); ++pos; } }
                const int total = __shfl(inc, 63);
                for (int z = total + lane; z < 256; z += 64) sl[z] = (unsigned short)0;
                if (lane == 63) selcnt[qi] = (unsigned)inc; }
            __syncthreads(); if (fast) PTICK(55);
#ifdef PROBE_PHASE
            unsigned long long tp1 = __builtin_amdgcn_s_memrealtime();
#endif
#pragma unroll 1
            for (int qq = 0; qq < 4; qq += 2) { const int qi = 4 * F.wave + qq; dsa_attend8z<2>(F, P, (const unsigned char*)CKV, OLAT, rowb, t0 + qi, qi);
#ifdef DBL_ATTEND
                dsa_attend<DBL_ATTEND>(F, P, CKV, OLAT, rowb, t0 + qi, qi);
#endif
            }
            LDS_WAIT();
            __syncthreads(); if (fast) PTICK(56);
            for (int u = F.tid; u < DS_BMAP / 16; u += 512) ((LAS u32x4*)hist)[u] = (u32x4){0u, 0u, 0u, 0u};
            __syncthreads(); if (fast) PTICK(57);
#ifdef PROBE_PHASE
            if (blockIdx.x == 0 && F.tid == 0) { unsigned long long tp2 = __builtin_amdgcn_s_memrealtime(); unsigned long long* ts = (unsigned long long*)(F.ws + WS_CTL + 131072); ts[40] += tp1 - tp0; ts[41] += tp2 - tp1; }
#endif
        }
    }
}

#ifndef MK_SINGLE
#define MK_SINGLE 1
#endif
constexpr int NPHASE = 2 + 9 * DEPTH;
struct Args { const float* in[22]; float* out; unsigned char* ws; int ph_lo, ph_hi; };

typedef const __attribute__((address_space(4))) Args* KArgsPtr;
DI void ctx_load(Ctx& F, LAS unsigned char* lds, int wave_s) {
    const __attribute__((address_space(4))) char* ka = (const __attribute__((address_space(4))) char*)__builtin_amdgcn_kernarg_segment_ptr();
    asm volatile("" : "+s"(ka));
    KArgsPtr a = (KArgsPtr)ka;
    int ln; asm volatile("v_mbcnt_lo_u32_b32 %0, -1, 0\n\tv_mbcnt_hi_u32_b32 %0, -1, %0" : "=v"(ln));
    asm volatile("" : "+s"(wave_s));
    F.lds = lds; F.lane = ln; F.wave = wave_s; F.tid = wave_s * 64 + ln;
    F.G = gridDim.x; { const int bx = blockIdx.x; F.vcu = (F.G % 8 == 0) ? (bx % 8) * (F.G / 8) + bx / 8 : bx; }
    F.x = a->in[0]; F.c = a->in[1]; F.rel_bias = a->in[2]; F.w_ada = a->in[3]; F.b_ada = a->in[4]; F.w_in = a->in[5]; F.g_kv = a->in[6]; F.w_uk = a->in[7]; F.w_uv = a->in[8];
    F.w_a_out = a->in[9]; F.w_b_out = a->in[10]; F.w_o = a->in[11]; F.ln1_g = a->in[12]; F.ln1_b = a->in[13]; F.w_router = a->in[14]; F.b_router = a->in[15];
    F.w_gu = a->in[16]; F.b_gu = a->in[17]; F.w_dn = a->in[18]; F.b_dn = a->in[19]; F.ln2_g = a->in[20]; F.ln2_b = a->in[21];
    F.out = a->out; F.ws = a->ws; F.ctl = (gu32*)(a->ws + WS_CTL);
}

__global__ void __launch_bounds__(512, 2) mega_fwd(Args args) {
    extern __shared__ __attribute__((aligned(16))) unsigned char lds_raw[];
    LAS unsigned char* const lds = (LAS unsigned char*)lds_raw;
    const int wave_s = __builtin_amdgcn_readfirstlane((int)(threadIdx.x >> 6));
    for (int u = threadIdx.x; u < (LDS_BYTES - SCH_OFF) / 4; u += 512) ((LAS unsigned*)(lds + SCH_OFF))[u] = 0u;
    __syncthreads();
    volatile LAS unsigned* MISCW = (volatile LAS unsigned*)(lds + MISC_OFF);
    XcdBarrier bar; bar.bar = (unsigned*)((gu32*)(args.ws + WS_CTL) + CW_BAR); bar.x = 0; bar.st = nullptr;
    const int lo = args.ph_lo, hi = args.ph_hi;
    if (hi - lo > 1) bar = xcd_barrier_post(bar.bar, MISCW + 8);
    bar.wv = wave_s;
#ifndef PH_MASK
#define PH_MASK 0xffffffffu
#endif
#define PHSEL(k) ((PH_MASK >> ((k) < 2 ? (k) : 2 + ((k) - 2) % 9)) & 1u)
#define RUN(k) (PHSEL(k) && lo <= (k) && (k) < hi)
#ifdef PROBE_PHASE
#define STAMP(k) do { if (blockIdx.x == 0 && bar.wv == 0 && __builtin_amdgcn_mbcnt_hi(~0u, __builtin_amdgcn_mbcnt_lo(~0u, 0u)) == 0u) ((unsigned long long*)(args.ws + WS_CTL + 131072))[(k) + 1] = __builtin_amdgcn_s_memrealtime(); } while (0)
#else
#define STAMP(k) do { } while (0)
#endif
#if defined(PROBE_PHASE) || defined(COUNT_FB)
#define SEAM_LAST(k) ((k) + 1 == NPHASE)
#else
#define SEAM_LAST(k) false
#endif
#define SEAM(k) do { if (RUN((k) + 1) || SEAM_LAST(k)) { XcdBarrier b2_ = bar; asm volatile("" : "+s"(b2_.bar)); xcd_barrier(b2_); } STAMP(k); } while (0)
    LAS int* tstart = (LAS int*)(lds + SCH_OFF); LAS int* ecnt = tstart + 40;
    Ctx F;
#ifdef PROBE_PHASE
    if (blockIdx.x == 0 && threadIdx.x == 0) { ((unsigned long long*)(args.ws + WS_CTL + 131072))[0] = __builtin_amdgcn_s_memrealtime(); }
#endif

    if (RUN(0)) { ctx_load(F, lds, wave_s); p0_prologue(F); SEAM(0); }
    if (RUN(1)) { ctx_load(F, lds, wave_s); phase_lnmod0(F); SEAM(1); }
#pragma unroll 1
    for (int l = 0; l < DEPTH; ++l) {
        const int pb = 2 + 9 * l;
        if (RUN(pb + 0)) {
            ctx_load(F, lds, wave_s); unsigned char* ws = F.ws;
            DenseSched S; S.init(NTOK, NCOL, DM, ws + WS_WIN + (size_t)l * NCOL * DM, F.G, (int)blockIdx.x);
            EpiInProj E{(bf16_t*)(ws + WS_P), (float*)(ws + WS_MISC)};
            pg8::gemm_phase<1>(F.lds, (const void*)(ws + WS_H), DM, S, E, F.tid);
            SEAM(pb + 0);
        }
        if (RUN(pb + 1)) { ctx_load(F, lds, wave_s); phase_misc(F, l); SEAM(pb + 1); }
#ifdef PROBE_PHASE
        if (RUN(pb + 2)) { ctx_load(F, lds, wave_s); const unsigned long long tb0 = __builtin_amdgcn_s_memrealtime(); phase_dsa(F, l);
            if (F.tid == 0) { unsigned long long* ts = (unsigned long long*)(args.ws + WS_CTL + 131072); ts[64 + blockIdx.x] += __builtin_amdgcn_s_memrealtime() - tb0; }
            SEAM(pb + 2); }
#else
        if (RUN(pb + 2)) { ctx_load(F, lds, wave_s); phase_dsa(F, l); SEAM(pb + 2); }
#endif
        if (RUN(pb + 3)) {
            { ctx_load(F, lds, wave_s); unsigned char* ws = F.ws;
              DenseSched S; S.init(NTOK, DM, DM, ws + WS_WFA + (size_t)l * DM * DM, F.G, (int)blockIdx.x);
              EpiMergeA E{(const bf16_t*)(ws + WS_P), (bf16_t*)(ws + WS_T)};
              pg8::gemm_phase<1>(F.lds, (const void*)(ws + WS_OLAT), DM, S, E, F.tid); }
            __syncthreads();
            { ctx_load(F, lds, wave_s); unsigned char* ws = F.ws;
              DenseSched S; S.init(NTOK, DM, 512, ws + WS_WB + (size_t)l * DM * 512, F.G, (int)blockIdx.x);
              EpiMergeB E{(const bf16_t*)(ws + WS_P), (const bf16_t*)(ws + WS_T), (unsigned char*)(ws + WS_MERGED)};
              pg8::gemm_phase<1>(F.lds, (const void*)(ws + WS_OB), 512, S, E, F.tid); }
            SEAM(pb + 3);
        }
        if (RUN(pb + 4)) {
            ctx_load(F, lds, wave_s); unsigned char* ws = F.ws;
            const void* xin = (l == 0) ? (const void*)F.x : (const void*)(ws + WS_XB);
            const float* mod = (const float*)(ws + WS_MOD) + (size_t)l * 8 * 6144;
            DenseSched S; S.init(NTOK, DM, DM, ws + WS_WO + (size_t)l * DM * DM, F.G, (int)blockIdx.x);
            EpiWo E{xin, mod + 2 * DM, (bf16_t*)(ws + WS_ZX), l != 0};
            pg8::gemm_phase<1>(F.lds, (const void*)(ws + WS_MERGED), DM, S, E, F.tid);
            SEAM(pb + 4);
        }
        if (RUN(pb + 5)) { ctx_load(F, lds, wave_s); phase_ln_router(F, l); SEAM(pb + 5); }
        if (RUN(pb + 6) || RUN(pb + 7)) {
            ctx_load(F, lds, wave_s);
            if (wave_s == 0) {
                int ln_; asm volatile("v_mbcnt_lo_u32_b32 %0, -1, 0\n\tv_mbcnt_hi_u32_b32 %0, -1, %0" : "=v"(ln_));
                const int e = ln_ & 31; const int c = (int)__hip_atomic_load(F.ctl + CW_CNT + l * NEXP + e, RLX_AGENT);
                const int nt_ = (c + 255) >> 8; int inc = nt_;
#pragma unroll
                for (int o = 1; o < 32; o <<= 1) { const int n = __shfl_up(inc, o); if (e >= o) inc += n; }
                if (ln_ < 32) { ecnt[e] = c; tstart[e] = inc - nt_; if (e == 31) tstart[NEXP] = inc; }
            }
            __syncthreads();
        }
        if (RUN(pb + 6)) {
            ctx_load(F, lds, wave_s); unsigned char* ws = F.ws;
            MoeSched<true> S{tstart, ecnt, 8, __builtin_amdgcn_readfirstlane(tstart[NEXP]), F.G, (int)blockIdx.x, (const char*)(ws + WS_WGU + (size_t)l * NEXP * 2048 * 1024), (const unsigned*)(ws + WS_LIST)};
            EpiGateUp E{F.b_gu + (size_t)l * NEXP * 2048, (unsigned char*)(ws + WS_ACT)};
            pg8::gemm_phase<1>(F.lds, (const void*)(ws + WS_H), DM, S, E, F.tid);
            SEAM(pb + 6);
        }
        if (RUN(pb + 7)) {
            ctx_load(F, lds, wave_s); unsigned char* ws = F.ws;
            MoeSched<false> S{tstart, ecnt, 4, __builtin_amdgcn_readfirstlane(tstart[NEXP]), F.G, (int)blockIdx.x, (const char*)(ws + WS_WDN + (size_t)l * NEXP * 1024 * 1024), (const unsigned*)(ws + WS_LIST)};
            EpiDown E{F.b_dn + (size_t)l * NEXP * DM, (const unsigned*)(ws + WS_LIST), (const float*)(ws + WS_GATEL), (bf16_t*)(ws + WS_YS), tstart, ecnt};
            pg8::gemm_phase<1>(F.lds, (const void*)(ws + WS_ACT), DEXP, S, E, F.tid);
            SEAM(pb + 7);
        }
        if (RUN(pb + 8)) { ctx_load(F, lds, wave_s); phase_final(F, l, F.out, l + 1 < DEPTH); SEAM(pb + 8); }
    }
#ifdef COUNT_FB
    {
        const unsigned n = __hip_atomic_load((unsigned*)((gu32*)(args.ws + WS_CTL) + 12288), RLX_AGENT);
        const float v = sqrtf(10.0f * (float)(n + 1u));
        float* o = args.out;
        int ln_; asm volatile("v_mbcnt_lo_u32_b32 %0, -1, 0\n\tv_mbcnt_hi_u32_b32 %0, -1, %0" : "=v"(ln_));
        for (size_t i = (size_t)blockIdx.x * 512 + wave_s * 64 + ln_; i < (size_t)NTOK * DM; i += (size_t)gridDim.x * 512) o[i] = v;
    }
#endif
#ifdef PROBE_PHASE
    {
        const unsigned long long* ts = (const unsigned long long*)(args.ws + WS_CTL + 131072);
        unsigned long long ticks = 0;
        if (PROBE_PHASE < 2) ticks = ts[PROBE_PHASE + 1] - ts[PROBE_PHASE];
        else if (PROBE_PHASE < 11) { for (int l = 0; l < DEPTH; ++l) { const int k = 2 + 9 * l + (PROBE_PHASE - 2); ticks += ts[k + 1] - ts[k]; } }
        else if (PROBE_PHASE == 20) ticks = ts[40]; else if (PROBE_PHASE == 21) ticks = ts[41]; else if (PROBE_PHASE == 22) ticks = ts[42] + 10; else if (PROBE_PHASE >= 45 && PROBE_PHASE <= 49) ticks = ts[PROBE_PHASE];
        else if (PROBE_PHASE == 23) { for (int i = 0; i < (int)gridDim.x; ++i) ticks = ts[64 + i] > ticks ? ts[64 + i] : ticks; }
        else if (PROBE_PHASE == 24) { for (int i = 0; i < (int)gridDim.x; ++i) ticks += ts[64 + i]; ticks /= gridDim.x; }
        else if (PROBE_PHASE == 25) { ticks = ts[64]; for (int i = 0; i < (int)gridDim.x; ++i) ticks = ts[64 + i] < ticks ? ts[64 + i] : ticks; }
        else ticks = ts[NPHASE] - ts[0];
        if (PROBE_PHASE >= 100 && PROBE_PHASE <= 110) {
            const int pp = PROBE_PHASE - 100; unsigned long long tph = 0;
            if (pp < 2) tph = ts[pp + 1] - ts[pp]; else for (int l = 0; l < DEPTH; ++l) { const int k = 2 + 9 * l + (pp - 2); tph += ts[k + 1] - ts[k]; }
            const unsigned long long tot = ts[NPHASE - 1] - ts[0];
            ticks = (unsigned long long)(rintf(25.0f * (float)tph / (float)tot) * 400.0f) + 1; }
        if (PROBE_PHASE >= 61 && PROBE_PHASE <= 67) { unsigned long long tot = 0; for (int k = 51; k <= 57; ++k) tot += ts[k]; ticks = (unsigned long long)(rintf(20.0f * (float)ts[PROBE_PHASE - 10] / (float)tot) * 100.0f) + 1; }
        const float us = 0.01f * (float)ticks;
        const float usq = (PROBE_PHASE == 22 || (PROBE_PHASE >= 61 && PROBE_PHASE <= 67) || PROBE_PHASE >= 100) ? us : exp10f(rintf(10.0f * log10f(us)) * 0.1f);
        const float v = sqrtf(10.0f * usq);
        float* o = args.out;
        int ln_; asm volatile("v_mbcnt_lo_u32_b32 %0, -1, 0\n\tv_mbcnt_hi_u32_b32 %0, -1, %0" : "=v"(ln_));
        for (size_t i = (size_t)blockIdx.x * 512 + wave_s * 64 + ln_; i < (size_t)NTOK * DM; i += (size_t)gridDim.x * 512) o[i] = v;
    }
#endif
#undef RUN
#undef SEAM
}

extern "C" void kernel_launch(void* const* d_in, const int* in_sizes, int n_in, void* d_out, int out_size, void* d_ws, size_t ws_size, hipStream_t stream) {
    static int grid = 0;
    if (grid == 0) {
        if (n_in != 22 || out_size != NTOK * DM || ws_size < WS_END) { fprintf(stderr, "kernel_launch: unexpected shapes (n_in %d, out %d, ws %zu < %zu)\n", n_in, out_size, ws_size, (size_t)WS_END); grid = -1; return; }
        int dev = 0, cus = 0, per_cu = 0;
        if (hipGetDevice(&dev) != hipSuccess || hipDeviceGetAttribute(&cus, hipDeviceAttributeMultiprocessorCount, dev) != hipSuccess) { grid = -1; return; }
        if (hipFuncSetAttribute((const void*)mega_fwd, hipFuncAttributeMaxDynamicSharedMemorySize, LDS_BYTES) != hipSuccess) { fprintf(stderr, "kernel_launch: hipFuncSetAttribute failed\n"); grid = -1; return; }
        if (hipOccupancyMaxActiveBlocksPerMultiprocessor(&per_cu, (const void*)mega_fwd, 512, LDS_BYTES) != hipSuccess || per_cu < 1) fprintf(stderr, "kernel_launch: occupancy query says %d\n", per_cu);
        (void)hipGetLastError();
        grid = cus;
        if (grid > 256) grid = 256;
    }
    if (grid < 0) return;
    (void)hipMemsetAsync((char*)d_ws + WS_CTL, 0, CTL_ZERO_BYTES, stream);
    Args a{};
    for (int i = 0; i < 22; ++i) a.in[i] = (const float*)d_in[i];
    a.out = (float*)d_out; a.ws = (unsigned char*)d_ws;
#if MK_SINGLE
    a.ph_lo = 0; a.ph_hi = NPHASE;
    hipLaunchKernelGGL(mega_fwd, dim3(grid), dim3(512), LDS_BYTES, stream, a);
#else
    for (int p = 0; p < NPHASE; ++p) { a.ph_lo = p; a.ph_hi = p + 1; hipLaunchKernelGGL(mega_fwd, dim3(grid), dim3(512), LDS_BYTES, stream, a); }
#endif
}
```
